# Optimizing an MI355X kernel written in HIP

```python
import math
import jax, jax.numpy as jnp
from jax import lax
import numpy as np

D_MODEL = 1024
BATCH = 8
SEQ = 2048
DEPTH = 2

CTX_LEN = 256
GRID_W = 64
D_FF = 2816
N_MOD = 9
EPS = 1e-6

RWKV_HEADS = 4
RWKV_HEAD_DIM = 64
D_RWKV = RWKV_HEADS * RWKV_HEAD_DIM
DECAY_LORA = 64
AAA_LORA = 64
GATE_LORA = 128
GN_EPS = 64e-5
NORM_EPS = 1e-12
D_CONV = 256
CONV_WIDTH = 31
DIFF_HEADS = 4
DIFF_QK_DIM = 64
DIFF_V_DIM = 2 * DIFF_QK_DIM
D_DIFF = DIFF_HEADS * DIFF_V_DIM
Q_BLOCK = 128
ROPE_THETA = 10000.0
AXIS_DIM = DIFF_QK_DIM // 2
ROPE_FREQS = AXIS_DIM // 2

D_MIX = D_RWKV + D_CONV + D_DIFF
RWKV_IN = 3 * D_RWKV + 2 * DECAY_LORA + 2 * AAA_LORA + GATE_LORA
CONV_IN = 2 * D_CONV
DIFF_IN = 2 * DIFF_HEADS * 2 * DIFF_QK_DIM + D_DIFF
P_IN = RWKV_IN + CONV_IN + DIFF_IN

kernel_name = 'hybrid_rwkv7_conformer_diffattn_dit'

f32 = jnp.float32


def rmsnorm(x, g, eps=EPS):
    xf = x.astype(f32)
    y = xf * lax.rsqrt(jnp.mean(xf * xf, axis=-1, keepdims=True) + eps)
    return (y * g.astype(f32)).astype(x.dtype)


def layernorm(x, g, b, eps):
    xf = x.astype(f32)
    mu = jnp.mean(xf, axis=-1, keepdims=True)
    xc = xf - mu
    var = jnp.mean(xc * xc, axis=-1, keepdims=True)
    return (xc * lax.rsqrt(var + eps) * g.astype(f32) + b.astype(f32)).astype(x.dtype)


def modulate(h, shift, scale):
    return h * (1.0 + scale) + shift


def swiglu(h, w_in, w_out):
    gate, up = jnp.split(h @ w_in, 2, axis=-1)
    return (jax.nn.silu(gate) * up) @ w_out


def to_heads(t):
    return t.reshape(t.shape[:-1] + (RWKV_HEADS, RWKV_HEAD_DIM))


def centred_shift(f, mu_prev, mu_next):
    zero = jnp.zeros_like(f[:, :1])
    prev = jnp.concatenate([zero, f[:, :-1]], axis=1)
    nxt = jnp.concatenate([f[:, 1:], zero], axis=1)
    return f + mu_prev * (prev - f) + mu_next * (nxt - f)


def rwkv_prepare(f, mu, w0, w2, a0, a2, g2, kk_scale, ka_scale):
    b, n, _ = f.shape
    f = centred_shift(f, mu[0], mu[1])
    r = f[..., 0:D_RWKV]
    k = f[..., D_RWKV:2 * D_RWKV]
    v = f[..., 2 * D_RWKV:3 * D_RWKV]
    o = 3 * D_RWKV
    wd = f[..., o:o + 2 * DECAY_LORA].reshape(b, n, 2, DECAY_LORA)
    o = o + 2 * DECAY_LORA
    ad = f[..., o:o + 2 * AAA_LORA].reshape(b, n, 2, AAA_LORA)
    o = o + 2 * AAA_LORA
    gd = f[..., o:o + GATE_LORA]
    w_raw = w0[:, None, None, :] + jnp.einsum('bndr,drc->dbnc', jnp.tanh(wd), w2)
    decay = jnp.exp(-jnp.exp(-jax.nn.softplus(-w_raw.astype(f32)) - 0.5))
    a = jax.nn.sigmoid((a0[:, None, None, :] + jnp.einsum('bndr,drc->dbnc', ad, a2)).astype(f32))
    g = jax.nn.sigmoid(gd) @ g2
    kk = to_heads((k * kk_scale).astype(f32))
    kk = kk * lax.rsqrt(jnp.sum(kk * kk, axis=-1, keepdims=True) + NORM_EPS)
    k_dir = k.astype(f32)[None] * (1.0 + (a - 1.0) * ka_scale.astype(f32))
    return (to_heads(r.astype(f32)), to_heads(v.astype(f32)), g, to_heads(k_dir),
            to_heads(decay), -kk, kk[None] * to_heads(a))


def wkv_scan(r, decay, k, v, avec, bvec, s0, reverse):
    xs = tuple(jnp.moveaxis(t, 1, 0) for t in (r, decay, k, v, avec, bvec))

    def step(s, inp):
        r_t, w_t, k_t, v_t, a_t, b_t = inp
        sa = jnp.einsum('bhij,bhj->bhi', s, a_t)
        s = s * w_t[:, :, None, :] + sa[..., None] * b_t[:, :, None, :] + v_t[..., None] * k_t[:, :, None, :]
        y = jnp.einsum('bhij,bhj->bhi', s, r_t)
        return s, y

    s_final, ys = lax.scan(step, s0, xs, reverse=reverse)
    return jnp.moveaxis(ys, 0, 1), s_final


def rwkv_finish(y, r, k2, v, g, rk, ln_g, ln_b):
    b, n = y.shape[:2]
    yn = layernorm(y, ln_g.reshape(RWKV_HEADS, RWKV_HEAD_DIM), ln_b.reshape(RWKV_HEADS, RWKV_HEAD_DIM), GN_EPS)
    bonus = jnp.sum(r * (k2[0] + k2[1]) * rk.astype(f32), axis=-1, keepdims=True) * v
    return ((yn + bonus).reshape(b, n, D_RWKV) * g.astype(f32)).astype(g.dtype)


def conv_module(f, dw_w, dw_b, ln_g, ln_b):
    val, gate = jnp.split(f, 2, axis=-1)
    h = val * jax.nn.sigmoid(gate)
    h = lax.conv_general_dilated(h, dw_w[:, None, :].astype(h.dtype), window_strides=(1,),
                                 padding=((CONV_WIDTH // 2, CONV_WIDTH // 2),),
                                 dimension_numbers=('NWC', 'WIO', 'NWC'),
                                 feature_group_count=D_CONV) + dw_b
    return jax.nn.silu(layernorm(h, ln_g, ln_b, 1e-5))


def rope_2d_tables(n_rows):
    row = jnp.repeat(jnp.arange(n_rows, dtype=jnp.int32), GRID_W)
    col = jnp.tile(jnp.arange(GRID_W, dtype=jnp.int32), n_rows)
    inv = 1.0 / (ROPE_THETA ** (jnp.arange(ROPE_FREQS, dtype=f32) * 2.0 / AXIS_DIM))
    ang = jnp.stack([row, col], axis=-1).astype(f32)[..., None] * inv
    return jnp.cos(ang), jnp.sin(ang)


def apply_rope_2d(t, cos, sin):
    ts = t.astype(f32).reshape(t.shape[:-1] + (2, 2, ROPE_FREQS))
    t1 = ts[..., 0, :]
    t2 = ts[..., 1, :]
    cs = cos[None, :, None, None]
    sn = sin[None, :, None, None]
    out = jnp.stack([t1 * cs - t2 * sn, t2 * cs + t1 * sn], axis=-2)
    return out.reshape(t.shape).astype(t.dtype)


def diff_qkv(f):
    b, n, _ = f.shape
    hq = DIFF_HEADS * 2 * DIFF_QK_DIM
    q = f[..., 0:hq].reshape(b, n, DIFF_HEADS, 2, DIFF_QK_DIM)
    k = f[..., hq:2 * hq].reshape(b, n, DIFF_HEADS, 2, DIFF_QK_DIM)
    v = f[..., 2 * hq:].reshape(b, n, DIFF_HEADS, DIFF_V_DIM)
    return q, k, v


def diff_attend(q, k, v, lam):
    s = jnp.einsum('bqhmd,bkhmd->bhmqk', q, k).astype(f32) * (DIFF_QK_DIM ** -0.5)
    p = jax.nn.softmax(s, axis=-1)
    attn = p[:, :, 0] - lam * p[:, :, 1]
    return jnp.einsum('bhqk,bkhe->bqhe', attn.astype(v.dtype), v)


def diff_heads_out(o, norm_g, lam_init):
    b, n = o.shape[:2]
    return (rmsnorm(o, norm_g, 1e-5) * (1.0 - lam_init)).reshape(b, n, D_DIFF)


def token_mix(hx, hc, layer, w_in, w_out, mu, w0, w2, a0, a2, g2, kk_s, ka_s, rk, lnx_g, lnx_b,
              dw_w, dw_b, cln_g, cln_b, lam_vecs, dnorm_g, cos, sin, need_ctx):
    b, n, _ = hx.shape
    fx = hx @ w_in
    fc = hc @ w_in
    ax, bx, cx = fx[..., :RWKV_IN], fx[..., RWKV_IN:RWKV_IN + CONV_IN], fx[..., RWKV_IN + CONV_IN:]
    ac, bc, cc = fc[..., :RWKV_IN], fc[..., RWKV_IN:RWKV_IN + CONV_IN], fc[..., RWKV_IN + CONV_IN:]

    r_x, v_x, g_x, k_x2, w_x2, av_x, bv_x2 = rwkv_prepare(ax, mu, w0, w2, a0, a2, g2, kk_s, ka_s)
    r_c, v_c, g_c, k_c2, w_c2, av_c, bv_c2 = rwkv_prepare(ac, mu, w0, w2, a0, a2, g2, kk_s, ka_s)
    s0 = jnp.zeros((b, RWKV_HEADS, RWKV_HEAD_DIM, RWKV_HEAD_DIM), f32)
    y_cf, s_cf = wkv_scan(r_c, w_c2[0], k_c2[0], v_c, av_c, bv_c2[0], s0, False)
    y_cb, s_cb = wkv_scan(r_c, w_c2[1], k_c2[1], v_c, av_c, bv_c2[1], s0, True)
    y_xf, _ = wkv_scan(r_x, w_x2[0], k_x2[0], v_x, av_x, bv_x2[0], s_cf, False)
    y_xb, _ = wkv_scan(r_x, w_x2[1], k_x2[1], v_x, av_x, bv_x2[1], s_cb, True)
    out_a_x = rwkv_finish(y_xf + y_xb, r_x, k_x2, v_x, g_x, rk, lnx_g, lnx_b)

    out_b_x = conv_module(bx, dw_w, dw_b, cln_g, cln_b)

    lam_init = 0.8 - 0.6 * math.exp(-0.3 * layer)
    lv = lam_vecs.astype(f32)
    lam = jnp.exp(jnp.sum(lv[0] * lv[1])) - jnp.exp(jnp.sum(lv[2] * lv[3])) + lam_init
    q_x, k_x, v_xa = diff_qkv(cx)
    q_c, k_c, v_ca = diff_qkv(cc)
    q_x = apply_rope_2d(q_x, cos, sin)
    k_x = apply_rope_2d(k_x, cos, sin)
    k_all = jnp.concatenate([k_x, k_c], axis=1)
    v_all = jnp.concatenate([v_xa, v_ca], axis=1)
    nb = n // Q_BLOCK
    qb = jnp.moveaxis(q_x.reshape(b, nb, Q_BLOCK, DIFF_HEADS, 2, DIFF_QK_DIM), 1, 0)
    ob = lax.map(lambda qq: diff_attend(qq, k_all, v_all, lam), qb)
    o_x = jnp.moveaxis(ob, 0, 1).reshape(b, n, DIFF_HEADS, DIFF_V_DIM)
    out_c_x = diff_heads_out(o_x, dnorm_g, lam_init)

    out_x = jnp.concatenate([out_a_x, out_b_x, out_c_x], axis=-1) @ w_out
    if not need_ctx:
        return out_x, None
    out_a_c = rwkv_finish(y_cf + y_cb, r_c, k_c2, v_c, g_c, rk, lnx_g, lnx_b)
    out_b_c = conv_module(bc, dw_w, dw_b, cln_g, cln_b)
    out_c_c = diff_heads_out(diff_attend(q_c, k_c, v_ca, lam), dnorm_g, lam_init)
    out_c = jnp.concatenate([out_a_c, out_b_c, out_c_c], axis=-1) @ w_out
    return out_x, out_c


def setup_inputs(seed: int = 0) -> dict:
    key = jax.random.key(seed)
    ks = jax.random.split(key, 32)

    def nrm(k, shape, scale):
        return jax.random.normal(k, shape, f32) * scale

    return {
        'x': nrm(ks[0], (BATCH, SEQ, D_MODEL), 1.0),
        'c': nrm(ks[1], (BATCH, D_MODEL), 1.0),
        'ctx': nrm(ks[2], (BATCH, CTX_LEN, D_MODEL), 1.0),
        'c_ctx': nrm(ks[3], (D_MODEL,), 1.0),
        'ada_w': nrm(ks[4], (DEPTH, D_MODEL, N_MOD * D_MODEL), 0.5 * D_MODEL ** -0.5),
        'ada_b': nrm(ks[5], (DEPTH, N_MOD * D_MODEL), 0.02),
        'norm_g': 1.0 + nrm(ks[6], (DEPTH, 3, D_MODEL), 0.02),
        'ffn_w_in': nrm(ks[7], (DEPTH, 2, D_MODEL, 2 * D_FF), D_MODEL ** -0.5),
        'ffn_w_out': nrm(ks[8], (DEPTH, 2, D_FF, D_MODEL), D_FF ** -0.5),
        'mix_w_in': nrm(ks[9], (DEPTH, D_MODEL, P_IN), D_MODEL ** -0.5),
        'mix_w_out': nrm(ks[10], (DEPTH, D_MIX, D_MODEL), D_MIX ** -0.5),
        'rwkv_mu': jax.random.uniform(ks[11], (DEPTH, 2, RWKV_IN), f32, 0.0, 0.5),
        'rwkv_w0': jax.random.uniform(ks[12], (DEPTH, 2, D_RWKV), f32, -6.0, 0.0),
        'rwkv_w2': nrm(ks[13], (DEPTH, 2, DECAY_LORA, D_RWKV), 0.5 * DECAY_LORA ** -0.5),
        'rwkv_a0': nrm(ks[14], (DEPTH, 2, D_RWKV), 0.1),
        'rwkv_a2': nrm(ks[15], (DEPTH, 2, AAA_LORA, D_RWKV), 0.5 * AAA_LORA ** -0.5),
        'rwkv_g2': nrm(ks[16], (DEPTH, GATE_LORA, D_RWKV), GATE_LORA ** -0.5),
        'rwkv_kk': 0.85 + nrm(ks[17], (DEPTH, D_RWKV), 0.02),
        'rwkv_ka': 1.0 + nrm(ks[18], (DEPTH, D_RWKV), 0.02),
        'rwkv_rk': nrm(ks[19], (DEPTH, RWKV_HEADS, RWKV_HEAD_DIM), 0.1),
        'rwkv_ln_g': 1.0 + nrm(ks[20], (DEPTH, D_RWKV), 0.02),
        'rwkv_ln_b': nrm(ks[21], (DEPTH, D_RWKV), 0.02),
        'conv_dw_w': nrm(ks[22], (DEPTH, CONV_WIDTH, D_CONV), CONV_WIDTH ** -0.5),
        'conv_dw_b': nrm(ks[23], (DEPTH, D_CONV), 0.02),
        'conv_ln_g': 1.0 + nrm(ks[24], (DEPTH, D_CONV), 0.02),
        'conv_ln_b': nrm(ks[25], (DEPTH, D_CONV), 0.02),
        'diff_lam': nrm(ks[26], (DEPTH, 4, DIFF_QK_DIM), 0.1),
        'diff_norm_g': 1.0 + nrm(ks[27], (DEPTH, DIFF_V_DIM), 0.02),
        'final_g': 1.0 + nrm(ks[28], (D_MODEL,), 0.02),
    }


def reference(x, c, ctx, c_ctx, ada_w, ada_b, norm_g, ffn_w_in, ffn_w_out, mix_w_in, mix_w_out,
              rwkv_mu, rwkv_w0, rwkv_w2, rwkv_a0, rwkv_a2, rwkv_g2, rwkv_kk, rwkv_ka, rwkv_rk,
              rwkv_ln_g, rwkv_ln_b, conv_dw_w, conv_dw_b, conv_ln_g, conv_ln_b,
              diff_lam, diff_norm_g, final_g):
    n_rows = x.shape[1] // GRID_W
    cos, sin = rope_2d_tables(n_rows)
    cond_x = jax.nn.silu(c)
    cond_c = jax.nn.silu(c_ctx)
    for l in range(DEPTH):
        need_ctx = l < DEPTH - 1
        ml = jnp.split((cond_x @ ada_w[l] + ada_b[l])[:, None, :], N_MOD, axis=-1)
        mc = jnp.split((cond_c @ ada_w[l] + ada_b[l])[None, None, :], N_MOD, axis=-1)
        x = x + 0.5 * ml[2] * swiglu(modulate(rmsnorm(x, norm_g[l, 0]), ml[0], ml[1]), ffn_w_in[l, 0], ffn_w_out[l, 0])
        ctx = ctx + 0.5 * mc[2] * swiglu(modulate(rmsnorm(ctx, norm_g[l, 0]), mc[0], mc[1]), ffn_w_in[l, 0], ffn_w_out[l, 0])
        hx = modulate(rmsnorm(x, norm_g[l, 1]), ml[3], ml[4])
        hc = modulate(rmsnorm(ctx, norm_g[l, 1]), mc[3], mc[4])
        ox, oc = token_mix(hx, hc, l, mix_w_in[l], mix_w_out[l], rwkv_mu[l], rwkv_w0[l], rwkv_w2[l],
                           rwkv_a0[l], rwkv_a2[l], rwkv_g2[l], rwkv_kk[l], rwkv_ka[l], rwkv_rk[l],
                           rwkv_ln_g[l], rwkv_ln_b[l], conv_dw_w[l], conv_dw_b[l], conv_ln_g[l], conv_ln_b[l],
                           diff_lam[l], diff_norm_g[l], cos, sin, need_ctx)
        x = x + ml[5] * ox
        x = x + 0.5 * ml[8] * swiglu(modulate(rmsnorm(x, norm_g[l, 2]), ml[6], ml[7]), ffn_w_in[l, 1], ffn_w_out[l, 1])
        if need_ctx:
            ctx = ctx + mc[5] * oc
            ctx = ctx + 0.5 * mc[8] * swiglu(modulate(rmsnorm(ctx, norm_g[l, 2]), mc[6], mc[7]), ffn_w_in[l, 1], ffn_w_out[l, 1])
    return rmsnorm(x, final_g)
```

```cpp
#include <hip/hip_runtime.h>
#include <hip/hip_bf16.h>
#include <hip/hip_cooperative_groups.h>
#include <cstdio>
namespace cg = cooperative_groups;

typedef unsigned short u16;
using bf16x8 = __attribute__((ext_vector_type(8))) short;
using s16x4 = __attribute__((ext_vector_type(4))) short;
using f32x4 = __attribute__((ext_vector_type(4))) float;
using f32x16 = __attribute__((ext_vector_type(16))) float;
#define DI __device__ __forceinline__

constexpr int D = 1024, TX = 16384, TCX = 2048, T = 18432, DFF = 2816, PINP = 3328;
constexpr int NTHR = 512;
#define MIXPROBE 0
constexpr int LDS_BYTES = 131072 + 256;
constexpr int LDS_CTL = 131072;

constexpr size_t WS_WIN = 0;
constexpr size_t WS_WOUT = WS_WIN + 2ull * 5632 * 1024 * 2;
constexpr size_t WS_MIN = WS_WOUT + 2ull * 1024 * 2816 * 2;
constexpr size_t WS_MOUT = WS_MIN + 3328ull * 1024 * 2;
constexpr size_t WS_XC = WS_MOUT + 1024ull * 1024 * 2;
constexpr size_t WS_MOD = WS_XC + 2048ull * 1024 * 4;
constexpr size_t WS_ROPE = WS_MOD + 2ull * 9 * 9216 * 4;
constexpr size_t WS_MISC = WS_ROPE + 64 * 16 * 2 * 4;
constexpr size_t WS_BAR = WS_MISC + 256;
constexpr size_t BAR_BYTES = 3456 * 4;
constexpr size_t WS_LORA = WS_BAR + 16384;
constexpr size_t WS_H = WS_LORA + 196608ull * 2;
constexpr size_t WS_R1 = WS_H + (size_t)T * 1024 * 2;
constexpr size_t SZ256 = (size_t)T * 256 * 2;
constexpr size_t WS_ACT = WS_R1;
constexpr size_t WS_FR = WS_R1;
constexpr size_t WS_Y = WS_R1;
constexpr size_t WS_SLAB = WS_R1 + 112ull * 1024 * 1024;
constexpr size_t WS_FC = WS_FR + (size_t)T * 1152 * 2;
constexpr size_t WS_Q = WS_FC + (size_t)T * 512 * 2;
constexpr size_t WS_KK = WS_Q + (size_t)T * 512 * 2;
constexpr size_t WS_VT = WS_KK + (size_t)T * 512 * 2;
constexpr size_t WS_SC = WS_VT + (size_t)T * 512 * 2;
constexpr size_t WS_G = WS_SC + 9 * SZ256;
constexpr size_t WS_BON = WS_G + SZ256;
constexpr size_t WS_END = WS_BON + SZ256;

struct P {
  const float *x, *c, *ctx, *c_ctx, *ada_w, *ada_b, *norm_g, *ffn_w_in, *ffn_w_out, *mix_w_in, *mix_w_out,
      *mu, *w0, *w2, *a0, *a2, *g2, *kk, *ka, *rk, *ln_g, *ln_b, *dw_w, *dw_b, *cln_g, *cln_b, *lam, *dng, *final_g;
  float* out;
  unsigned char* ws;
  int ph_lo, ph_hi;
};

extern __shared__ __attribute__((aligned(16))) unsigned char smem[];

DI int otid() { int t = threadIdx.x; asm volatile("" : "+v"(t)); return t; }
DI int obid() { int b = blockIdx.x; asm volatile("" : "+s"(b)); return b; }
DI u16 f2bf(float x) { __bf16 b = (__bf16)x; return __builtin_bit_cast(u16, b); }
DI float bf2f(u16 h) { return __uint_as_float(((unsigned)h) << 16); }
DI unsigned pack2(float a, float b) { return (unsigned)f2bf(a) | ((unsigned)f2bf(b) << 16); }
DI float sigm(float x) { return __builtin_amdgcn_rcpf(1.f + __builtin_amdgcn_exp2f(-1.4426950408889634f * x)); }
DI float wave_sum(float v);
template <int CTRL> DI float dppx(float v) {
  return __int_as_float(__builtin_amdgcn_update_dpp(0, __float_as_int(v), CTRL, 0xF, 0xF, true));
}
DI float allred16(float v) {
  v += dppx<0xB1>(v); v += dppx<0x4E>(v); v += dppx<0x141>(v); v += dppx<0x140>(v);
  return v;
}
DI float wave_sum(float v) {
  v = allred16(v);
  v += __shfl_xor(v, 16);
  v += __shfl_xor(v, 32);
  return v;
}
DI float* xrow(const P& p, int row) {
  return row < TX ? p.out + (size_t)row * D : (float*)(p.ws + WS_XC) + (size_t)(row - TX) * D;
}

DI void tr_tile(const float* W, int N, int K, u16* Wt, int kt, int ntile, int mode) {
  float* tile = (float*)smem;
  const int tid = otid();
  const int k0 = kt * 64, np0 = ntile * 64;
  int n0 = np0; bool valid = true;
  if (mode == 1) { int tl = np0 >> 8, half = (np0 >> 7) & 1, jj = np0 & 127; n0 = half * DFF + tl * 128 + jj; }
  if (mode == 2) { valid = np0 < 3200; }
  {
    const int kr = tid >> 4, nc = (tid & 15) * 4;
#pragma unroll
    for (int pz = 0; pz < 2; ++pz) {
      const int k = kr + 32 * pz;
      float4 v = make_float4(0.f, 0.f, 0.f, 0.f);
      if (valid) v = *(const float4*)&W[(size_t)(k0 + k) * N + n0 + nc];
      tile[k * 65 + nc + 0] = v.x; tile[k * 65 + nc + 1] = v.y; tile[k * 65 + nc + 2] = v.z; tile[k * 65 + nc + 3] = v.w;
    }
  }
  __syncthreads();
  {
    const int np = tid >> 3, ks = (tid & 7) * 8;
    uint4 o;
    o.x = pack2(tile[(ks + 0) * 65 + np], tile[(ks + 1) * 65 + np]);
    o.y = pack2(tile[(ks + 2) * 65 + np], tile[(ks + 3) * 65 + np]);
    o.z = pack2(tile[(ks + 4) * 65 + np], tile[(ks + 5) * 65 + np]);
    o.w = pack2(tile[(ks + 6) * 65 + np], tile[(ks + 7) * 65 + np]);
    *(uint4*)&Wt[(size_t)(np0 + np) * K + k0 + ks] = o;
  }
  __syncthreads();
}

DI void mod_item(const P& p, int idx) {
  float* cond = (float*)smem;
  float* red = cond + 9216;
  const int tid = otid(), lane = tid & 63, w = tid >> 6;
  const int l2 = idx / 144, n0 = (idx % 144) * 64;
  for (int i = tid; i < 9216; i += NTHR) {
    int m = i >> 10, k = i & 1023;
    float v = m < 8 ? p.c[m * 1024 + k] : p.c_ctx[k];
    cond[i] = v * sigm(v);
  }
  __syncthreads();
  float acc[9];
#pragma unroll
  for (int m = 0; m < 9; ++m) acc[m] = 0.f;
  const float* wp = p.ada_w + ((size_t)l2 * 1024 + w * 128) * 9216 + n0 + lane;
#pragma unroll 4
  for (int k = 0; k < 128; ++k) {
    float wv = wp[(size_t)k * 9216];
#pragma unroll
    for (int m = 0; m < 9; ++m) acc[m] += cond[m * 1024 + w * 128 + k] * wv;
  }
#pragma unroll
  for (int m = 0; m < 9; ++m) red[(w * 9 + m) * 64 + lane] = acc[m];
  __syncthreads();
  float* mod = (float*)(p.ws + WS_MOD);
  for (int o = tid; o < 576; o += NTHR) {
    int m = o >> 6, ln = o & 63;
    float s = 0.f;
#pragma unroll
    for (int ww = 0; ww < 8; ++ww) s += red[(ww * 9 + m) * 64 + ln];
    mod[(size_t)(l2 * 9 + m) * 9216 + n0 + ln] = s + p.ada_b[l2 * 9216 + n0 + ln];
  }
  __syncthreads();
}

DI void misc_item(const P& p) {
  const int tid = otid();
  float* rope = (float*)(p.ws + WS_ROPE);
  for (int i = tid; i < 1024; i += NTHR) {
    int pos = i >> 4, f = i & 15;
    float inv = exp2f(-(float)f * (13.287712379549449f / 16.f));
    float ang = (float)pos * inv;
    float kq = rintf(ang * 0.15915494309189535f);
    float r = fmaf(-kq, 6.28125f, ang);
    r = fmaf(-kq, 1.9353071795864769e-3f, r);
    rope[i * 2 + 0] = cosf(r);
    rope[i * 2 + 1] = sinf(r);
  }
  if (tid < 2) {
    const float* lv = p.lam + tid * 256;
    float s1 = 0.f, s2 = 0.f;
    for (int i = 0; i < 64; ++i) { s1 += lv[i] * lv[64 + i]; s2 += lv[128 + i] * lv[192 + i]; }
    float li = 0.8f - 0.6f * expf(-0.3f * (float)tid);
    float* mf = (float*)(p.ws + WS_MISC);
    mf[tid] = expf(s1) - expf(s2) + li;
    mf[2 + tid] = li;
  }
  if (tid >= 8 && tid < 32) ((unsigned*)(p.ws + WS_MISC))[tid] = 0u;
}

DI void lora_item(const P& p, int i) {
  u16* LW = (u16*)(p.ws + WS_LORA);
  const int tid = otid();
#pragma unroll
  for (int q = 0; q < 4; ++q) {
    const int e = i * 2048 + q * NTHR + tid;
    float v;
    if (e < 131072) {
      const int e1 = e & 65535, r = e1 & 63, c = (e1 >> 6) & 255, ld = e1 >> 14;
      const float* src = e < 65536 ? p.w2 : p.a2;
      v = src[((size_t)ld * 64 + r) * 256 + c];
    } else {
      const int e1 = e - 131072, r = e1 & 127, c = (e1 >> 7) & 255, l_ = e1 >> 15;
      v = p.g2[((size_t)l_ * 128 + r) * 256 + c];
    }
    LW[e] = f2bf(v);
  }
}

DI void prep_phase(const P& p, int l) {
  const int nconv = 2816 + 1408 + 832 + 256;
  const int total = nconv + (l == 0 ? 289 + 96 : 0);
  for (int it = obid(); it < total; it += gridDim.x) {
    if (it < 2816) {
      int s = it / 1408, r = it % 1408;
      tr_tile(p.ffn_w_in + (size_t)(l * 2 + s) * 1024 * 5632, 5632, 1024, (u16*)(p.ws + WS_WIN) + (size_t)s * 5632 * 1024, r / 88, r % 88, 1);
    } else if (it < 2816 + 1408) {
      int q = it - 2816; int s = q / 704, r = q % 704;
      tr_tile(p.ffn_w_out + (size_t)(l * 2 + s) * 2816 * 1024, 1024, 2816, (u16*)(p.ws + WS_WOUT) + (size_t)s * 1024 * 2816, r / 16, r % 16, 0);
    } else if (it < 2816 + 1408 + 832) {
      int r = it - 4224;
      tr_tile(p.mix_w_in + (size_t)l * 1024 * 3200, 3200, 1024, (u16*)(p.ws + WS_MIN), r / 52, r % 52, 2);
    } else if (it < nconv) {
      int r = it - 5056;
      tr_tile(p.mix_w_out + (size_t)l * 1024 * 1024, 1024, 1024, (u16*)(p.ws + WS_MOUT), r / 16, r % 16, 0);
    } else if (it < nconv + 288) {
      mod_item(p, it - nconv);
    } else if (it == nconv + 288) {
      misc_item(p);
    } else {
      lora_item(p, it - nconv - 289);
    }
  }
}

DI void norm_phase(const P& p, int l, int gi, int si, bool first, int rows, int nslab = 0) {
  const int lane = otid() & 63, w = otid() >> 6;
  const float* modb = (const float*)(p.ws + WS_MOD);
  u16* H = (u16*)(p.ws + WS_H);
  const float* g = p.norm_g + (size_t)(l * 3 + gi) * 1024;
  const int nw = (int)gridDim.x * 8, wid = obid() * 8 + w;
  const int per = nw >> 3;
  const bool grouped = (nw & 7) == 0 && per > 0 && (2048 % per) == 0;
  const int grp = grouped ? wid / per : 0, sub = grouped ? wid - grp * per : 0;
  const int nx = grouped ? 2048 / per : 0;
  const int nsteps = grouped ? nx + ((rows > TX) ? (TCX + nw - 1) / nw : 0) : (rows + nw - 1) / nw;
  int cur_m = -1;
  f32x4 A[4], B[4];
  for (int st = 0; st < nsteps; ++st) {
    int row;
    if (!grouped) { row = st * nw + wid; if (row >= rows) break; }
    else if (st < nx) row = grp * 2048 + st * per + sub;
    else { row = TX + (st - nx) * nw + wid; if (row >= rows) break; }
    const int mrow = row < TX ? (row >> 11) : 8;
    if (mrow != cur_m) {
      const float* md = modb + (size_t)(l * 9 + mrow) * 9216;
#pragma unroll
      for (int c = 0; c < 4; ++c) {
        const int k = (c >> 1) * 512 + lane * 8 + (c & 1) * 4;
        const f32x4 g4 = *(const f32x4*)&g[k], sh = *(const f32x4*)&md[si * 1024 + k], sc = *(const f32x4*)&md[(si + 1) * 1024 + k];
        A[c] = g4 * (sc + 1.f); B[c] = sh;
      }
      cur_m = mrow;
    }
    const float* src = first ? (row < TX ? p.x + (size_t)row * D : p.ctx + (size_t)(row - TX) * D) : xrow(p, row);
    f32x4 v[4];
    const bool addsl = nslab > 0 && row >= TX;
#pragma unroll
    for (int c = 0; c < 4; ++c) v[c] = *(const f32x4*)&src[(c >> 1) * 512 + lane * 8 + (c & 1) * 4];
    if (addsl) {
      const float* sl = (const float*)(p.ws + WS_SLAB) + (size_t)(row - TX) * D;
      for (int q = 0; q < nslab; ++q) {
#pragma unroll
        for (int c = 0; c < 4; ++c) v[c] += *(const f32x4*)&sl[(size_t)q * TCX * D + (c >> 1) * 512 + lane * 8 + (c & 1) * 4];
      }
    }
    float ss = 0.f;
#pragma unroll
    for (int c = 0; c < 4; ++c) ss += v[c][0] * v[c][0] + v[c][1] * v[c][1] + v[c][2] * v[c][2] + v[c][3] * v[c][3];
    ss = wave_sum(ss);
    const float rstd = rsqrtf(ss * (1.f / 1024.f) + 1e-6f);
    float* xd = xrow(p, row);
#pragma unroll
    for (int c2 = 0; c2 < 2; ++c2) {
      const f32x4 ha = v[2 * c2] * rstd * A[2 * c2] + B[2 * c2], hb = v[2 * c2 + 1] * rstd * A[2 * c2 + 1] + B[2 * c2 + 1];
      *(uint4*)&H[(size_t)row * 1024 + c2 * 512 + lane * 8] = make_uint4(pack2(ha[0], ha[1]), pack2(ha[2], ha[3]), pack2(hb[0], hb[1]), pack2(hb[2], hb[3]));
      if (first || addsl) { *(f32x4*)&xd[c2 * 512 + lane * 8] = v[2 * c2]; *(f32x4*)&xd[c2 * 512 + lane * 8 + 4] = v[2 * c2 + 1]; }
    }
  }
}

DI void final_phase(const P& p) {
  const int lane = otid() & 63, w = otid() >> 6;
  float4 gq[4];
#pragma unroll
  for (int c = 0; c < 4; ++c) gq[c] = ((const float4*)p.final_g)[c * 64 + lane];
  for (int row = obid() * 8 + w; row < TX; row += gridDim.x * 8) {
    float* src = p.out + (size_t)row * D;
    float4 v[4];
    float ss = 0.f;
#pragma unroll
    for (int c = 0; c < 4; ++c) {
      v[c] = ((const float4*)src)[c * 64 + lane];
      ss += v[c].x * v[c].x + v[c].y * v[c].y + v[c].z * v[c].z + v[c].w * v[c].w;
    }
    ss = wave_sum(ss);
    const float rstd = rsqrtf(ss * (1.f / 1024.f) + 1e-6f);
#pragma unroll
    for (int c = 0; c < 4; ++c) {
      const float4 g4 = gq[c];
      float4 o = make_float4(v[c].x * rstd * g4.x, v[c].y * rstd * g4.y, v[c].z * rstd * g4.z, v[c].w * rstd * g4.w);
      ((float4*)src)[c * 64 + lane] = o;
    }
  }
}

#define LAS __attribute__((address_space(3)))
constexpr int BM = 256, BK = 64, HALF = 128, HTB = HALF * BK * 2;
DI int lds_byte(int r, int c) { const int st = (r >> 4) * 2 + (c >> 5), rr = r & 15, cc = c & 31, ob = rr * 64 + cc * 2; return st * 1024 + (ob ^ (((ob >> 9) & 1) << 5)); }
DI void stage_rc(int b, int& R, int& C) { const int st = b / 1024, sb = b % 1024, swz = sb ^ (((sb >> 9) & 1) << 5); R = (st >> 1) * 16 + swz / 64; C = (st & 1) * 32 + (swz % 64) / 2; }
DI int perm32(int rho) { const int n = rho >> 4, i = rho & 15; return 8 * (i >> 2) + 4 * n + (i & 3); }
struct Unit { int pm, pn, k0, nkt, q; };
struct Gemm { const u16* A; const u16* Bt; int M, N, K; };
struct StaticOrder {
  int nM, nN, nwg, G, c, nkt, S, ntail;
  DI void init(int M, int N, int K, int G_, int c_, int Mx, int S_) {
    nN = N / BM; G = G_; c = c_; nkt = K / BK; S = S_;
    nM = (S_ > 0 ? Mx : M) / BM; nwg = nM * nN;
    ntail = S_ > 0 ? ((M - Mx) / BM) * nN * S_ : 0;
  }
  DI bool next(int i, Unit& u) const {
    const long L = (long)i * G + c;
    if (L >= nwg + ntail) return false;
    if (L >= nwg) {
      const int r = (int)L - nwg, tt = r / S, q = r - tt * S, nkp = nkt >> 1;
      const int kp0 = (q * nkp) / S, kp1 = ((q + 1) * nkp) / S;
      u.pm = nM + tt / nN; u.pn = tt % nN; u.k0 = 2 * kp0; u.nkt = 2 * (kp1 - kp0); u.q = q;
      return true;
    }
    int wgid = (int)L; { const int q = nwg / 8, r = nwg % 8, xcd = wgid % 8, off = wgid / 8; wgid = (xcd < r ? xcd * (q + 1) : r * (q + 1) + (xcd - r) * q) + off; }
    const int nig = 8 * nN, gid = wgid / nig, fm = gid * 8, gsz = (nM - fm) < 8 ? (nM - fm) : 8;
    u.pm = fm + ((wgid % nig) % gsz); u.pn = (wgid % nig) / gsz; u.k0 = 0; u.nkt = nkt; u.q = 0; return true;
  }
};

struct EpiSwiglu {
  static constexpr bool PERM = true;
  u16* ACT;
  DI void operator()(const f32x4 (&acc)[2][2][4][2], const Unit& u, int wr, int wc, int fr, int fq) const {
    const int row0 = u.pm * BM + wr * 64 + fr, col0 = u.pn * 128 + wc * 32 + 8 * fq;
#pragma unroll
    for (int ai = 0; ai < 2; ++ai)
#pragma unroll
      for (int m = 0; m < 4; ++m) {
        const int row = row0 + ai * HALF + m * 16;
        float v[8];
#pragma unroll
        for (int n = 0; n < 2; ++n)
#pragma unroll
          for (int e = 0; e < 4; ++e) { const float gt = acc[ai][0][m][n][e], up = acc[ai][1][m][n][e]; v[n * 4 + e] = gt * sigm(gt) * up; }
        uint4 o; o.x = pack2(v[0], v[1]); o.y = pack2(v[2], v[3]); o.z = pack2(v[4], v[5]); o.w = pack2(v[6], v[7]);
        *(uint4*)&ACT[(size_t)row * DFF + col0] = o;
      }
  }
};
struct EpiResid {
  static constexpr bool PERM = false;
  float* out; unsigned char* ws; int l, gidx, half, tail;
  DI void operator()(const f32x4 (&acc)[2][2][4][2], const Unit& u, int wr, int wc, int fr, int fq) const {
    float* xc = (float*)(ws + WS_XC); const float* mod = (const float*)(ws + WS_MOD); float* slab = (float*)(ws + WS_SLAB);
    const float sc = half ? 0.5f : 1.f;
    const int brow = u.pm * BM;
    const int mrow = brow < TX ? (brow >> 11) : 8;
    const int col0 = u.pn * BM + wc * 32 + 4 * fq;
    const float* gate = mod + (size_t)(l * 9 + mrow) * 9216 + gidx * 1024 + col0;
    f32x4 gv[2][2];
#pragma unroll
    for (int bj = 0; bj < 2; ++bj)
#pragma unroll
      for (int n = 0; n < 2; ++n) gv[bj][n] = *(const f32x4*)(gate + bj * HALF + n * 16) * sc;
    if (tail && brow >= TX) {
      float* sp0 = slab + ((size_t)u.q * TCX + (size_t)(brow - TX + wr * 64 + fr)) * D + col0;
#pragma unroll
      for (int ai = 0; ai < 2; ++ai)
#pragma unroll
        for (int m = 0; m < 4; ++m)
#pragma unroll
          for (int bj = 0; bj < 2; ++bj)
#pragma unroll
            for (int n = 0; n < 2; ++n) *(f32x4*)(sp0 + (size_t)(ai * HALF + m * 16) * D + bj * HALF + n * 16) = gv[bj][n] * acc[ai][bj][m][n];
      return;
    }
#pragma unroll
    for (int ai = 0; ai < 2; ++ai) {
      f32x4 xv[4][2][2];
      float* xp0 = (brow < TX ? out + (size_t)(brow + ai * HALF + wr * 64 + fr) * D : xc + (size_t)(brow - TX + ai * HALF + wr * 64 + fr) * D) + col0;
#pragma unroll
      for (int m = 0; m < 4; ++m)
#pragma unroll
        for (int bj = 0; bj < 2; ++bj)
#pragma unroll
          for (int n = 0; n < 2; ++n) xv[m][bj][n] = *(const f32x4*)(xp0 + (size_t)m * 16 * D + bj * HALF + n * 16);
#pragma unroll
      for (int m = 0; m < 4; ++m)
#pragma unroll
        for (int bj = 0; bj < 2; ++bj)
#pragma unroll
          for (int n = 0; n < 2; ++n) *(f32x4*)(xp0 + (size_t)m * 16 * D + bj * HALF + n * 16) = xv[m][bj][n] + gv[bj][n] * acc[ai][bj][m][n];
    }
  }
};
struct EpiMix {
  static constexpr bool PERM = false;
  unsigned char* ws;
  DI void operator()(const f32x4 (&acc)[2][2][4][2], const Unit& u, int wr, int wc, int fr, int fq) const {
    const float* rope = (const float*)(ws + WS_ROPE);
    const int brow = u.pm * BM, bcol = u.pn * BM;
    const bool isx = brow < TX;
    const int bb = isx ? (brow >> 11) : ((brow - TX) >> 8);
#pragma unroll
    for (int bj = 0; bj < 2; ++bj) {
      const int base32 = bcol + bj * HALF + wc * 32;
      if (base32 >= 3200) continue;
      if (base32 < 1664) {
        u16* dst; int ld, cb;
        if (base32 < 1152) { dst = (u16*)(ws + WS_FR); ld = 1152; cb = base32; }
        else { dst = (u16*)(ws + WS_FC); ld = 512; cb = base32 - 1152; }
#pragma unroll
        for (int ai = 0; ai < 2; ++ai)
#pragma unroll
          for (int m = 0; m < 4; ++m) {
            const int row = brow + ai * HALF + wr * 64 + m * 16 + fr;
            const uint2 q0 = make_uint2(pack2(acc[ai][bj][m][0][0], acc[ai][bj][m][0][1]), pack2(acc[ai][bj][m][0][2], acc[ai][bj][m][0][3]));
            const uint2 q1 = make_uint2(pack2(acc[ai][bj][m][1][0], acc[ai][bj][m][1][1]), pack2(acc[ai][bj][m][1][2], acc[ai][bj][m][1][3]));
            const bool od = fq & 1;
            const uint2 snd = od ? q0 : q1;
            const uint2 rcv = make_uint2((unsigned)__shfl_xor((int)snd.x, 16), (unsigned)__shfl_xor((int)snd.y, 16));
            const uint4 o4 = od ? make_uint4(rcv.x, rcv.y, q1.x, q1.y) : make_uint4(q0.x, q0.y, rcv.x, rcv.y);
            *(uint4*)&dst[(size_t)row * ld + cb + (od ? 16 + 4 * (fq - 1) : 4 * fq)] = o4;
          }
      } else if (base32 < 2688) {
        const bool isq = base32 < 2176;
        const int cb = isq ? base32 - 1664 : base32 - 2176;
        const int axis = (base32 >> 5) & 1;
        const float qs = isq ? 0.125f * 1.4426950408889634f : 1.f;
#pragma unroll
        for (int ai = 0; ai < 2; ++ai)
#pragma unroll
          for (int m = 0; m < 4; ++m) {
            const int row = brow + ai * HALF + wr * 64 + m * 16 + fr;
            f32x4 t1 = acc[ai][bj][m][0], t2 = acc[ai][bj][m][1];
            int keyidx;
            if (isx) {
              const int npos = row & 2047;
              const int ps = axis ? (npos & 63) : (npos >> 6);
              const f32x4 ca = *(const f32x4*)&rope[(ps * 16 + 4 * fq) * 2];
              const f32x4 cb4 = *(const f32x4*)&rope[(ps * 16 + 4 * fq) * 2 + 4];
              const f32x4 cs = {ca[0], ca[2], cb4[0], cb4[2]}, sn = {ca[1], ca[3], cb4[1], cb4[3]};
              const f32x4 o1 = t1 * cs - t2 * sn, o2 = t2 * cs + t1 * sn;
              t1 = o1; t2 = o2; keyidx = npos;
            } else keyidx = 2048 + ((row - TX) & 255);
            t1 = t1 * qs; t2 = t2 * qs;
            const uint2 q0 = make_uint2(pack2(t1[0], t1[1]), pack2(t1[2], t1[3]));
            const uint2 q1 = make_uint2(pack2(t2[0], t2[1]), pack2(t2[2], t2[3]));
            const bool od = fq & 1;
            const uint2 snd = od ? q0 : q1;
            const uint2 rcv = make_uint2((unsigned)__shfl_xor((int)snd.x, 16), (unsigned)__shfl_xor((int)snd.y, 16));
            const uint4 o4 = od ? make_uint4(rcv.x, rcv.y, q1.x, q1.y) : make_uint4(q0.x, q0.y, rcv.x, rcv.y);
            u16* dst = isq ? (u16*)(ws + WS_Q) + (size_t)row * 512 + cb
                           : (u16*)(ws + WS_KK) + ((size_t)bb * 2304 + keyidx) * 512 + cb;
            *(uint4*)(dst + (od ? 16 + 4 * (fq - 1) : 4 * fq)) = o4;
          }
      } else {
        u16* VT = (u16*)(ws + WS_VT);
        const int cb = base32 - 2688;
#pragma unroll
        for (int ai = 0; ai < 2; ++ai)
#pragma unroll
          for (int m = 0; m < 4; ++m) {
            const int rowb = brow + ai * HALF + wr * 64 + m * 16 + (fr & ~3);
            const int keyb = isx ? (rowb & 2047) : 2048 + ((rowb - TX) & 255);
            const bool od1 = fr & 1, od2 = (fr >> 1) & 1;
            unsigned own[8];
#pragma unroll
            for (int n = 0; n < 2; ++n)
#pragma unroll
              for (int e = 0; e < 4; ++e) own[n * 4 + e] = (unsigned)f2bf(acc[ai][bj][m][n][e]);
            unsigned pr[4];
#pragma unroll
            for (int i = 0; i < 4; ++i) {
              const unsigned snd = od1 ? own[i] : own[4 + i], kp = od1 ? own[4 + i] : own[i];
              const unsigned rc = (unsigned)__builtin_amdgcn_update_dpp(0, (int)snd, 0xB1, 0xF, 0xF, true);
              pr[i] = od1 ? (rc | (kp << 16)) : (kp | (rc << 16));
            }
#pragma unroll
            for (int j = 0; j < 2; ++j) {
              const unsigned snd = od2 ? pr[j] : pr[2 + j], kp = od2 ? pr[2 + j] : pr[j];
              const unsigned rc = (unsigned)__builtin_amdgcn_update_dpp(0, (int)snd, 0x4E, 0xF, 0xF, true);
              const uint2 o2 = od2 ? make_uint2(rc, kp) : make_uint2(kp, rc);
              const int cc = cb + (od1 ? 16 : 0) + 4 * fq + (od2 ? 2 : 0) + j;
              *(uint2*)&VT[((size_t)bb * 512 + cc) * 2304 + keyb] = o2;
            }
          }
      }
    }
  }
};

template <class Epi>
DI void gemm_phase(const Gemm g, const Epi& E, int Mx = 0, int S_ = 0) {
  LAS unsigned char* lds = (LAS unsigned char*)smem;
  StaticOrder S; S.init(g.M, g.N, g.K, (int)gridDim.x, (int)obid(), Mx, S_);
  const int tid = otid(), wid = __builtin_amdgcn_readfirstlane(tid >> 6), lane = tid & 63, wr = wid >> 2, wc = wid & 3, fr = lane & 15, fq = lane >> 4;
  const int K = g.K;
  unsigned voffA[2], voffB[2];
#pragma unroll
  for (int i = 0; i < 2; ++i) { int R, C; stage_rc(tid * 16 + i * 8192, R, C); const int Rb = Epi::PERM ? ((R & ~31) + perm32(R & 31)) : R;
    voffA[i] = (unsigned)(R * K + C) * 2u; voffB[i] = (unsigned)(Rb * K + C) * 2u; }
  const size_t kstep = (size_t)(BK * 2);
  const size_t hstep = (size_t)HALF * K * 2;
  const size_t tstep = 2 * hstep;
  const unsigned ldsw = (unsigned)wid * 1024u;
  const int aoff = lds_byte(wr * 64 + fr, fq * 8), boff = lds_byte(wc * 32 + fr, fq * 8);
#define PG8_SA(b, h) (((b) * 2 + (h)) * HTB)
#define PG8_SB(b, h) ((4 + (b) * 2 + (h)) * HTB)
#define PG8_STAGE(bufoff, gbase, voff) do { _Pragma("unroll") for (int _i = 0; _i < 2; ++_i) \
    __builtin_amdgcn_global_load_lds((const unsigned*)((const char*)(gbase) + (voff)[_i]), (LAS unsigned*)(lds + (bufoff) + ldsw + _i * 8192), 16, 0, 0); } while (0)
#define PG8_LDA(dst, b, h) do { _Pragma("unroll") for (int m = 0; m < 4; ++m) _Pragma("unroll") for (int k = 0; k < 2; ++k) dst[m][k] = *(const LAS bf16x8*)(lds + PG8_SA(b, h) + aoff + m * 2048 + k * 1024); } while (0)
#define PG8_LDB(dst, b, h) do { _Pragma("unroll") for (int n = 0; n < 2; ++n) _Pragma("unroll") for (int k = 0; k < 2; ++k) dst[n][k] = *(const LAS bf16x8*)(lds + PG8_SB(b, h) + boff + n * 2048 + k * 1024); } while (0)
#define PG8_MMA(ai, bj, At, Bt) do { __builtin_amdgcn_s_setprio(1); _Pragma("unroll") for (int m = 0; m < 4; ++m) _Pragma("unroll") for (int n = 0; n < 2; ++n) _Pragma("unroll") for (int k = 0; k < 2; ++k) \
    acc[ai][bj][m][n] = __builtin_amdgcn_mfma_f32_16x16x32_bf16(Bt[n][k], At[m][k], acc[ai][bj][m][n], 0, 0, 0); __builtin_amdgcn_s_setprio(0); } while (0)
#define PG8_WAIT_V(n) asm volatile("s_waitcnt vmcnt(" #n ")" ::: "memory")
#define PG8_WAIT_L(n) asm volatile("s_waitcnt lgkmcnt(" #n ")" ::: "memory")
#define PG8_BAR __builtin_amdgcn_s_barrier()
#define PG8_SCHED __builtin_amdgcn_sched_barrier(0)
  Unit cur, nxt; int ui = 0;
  if (!S.next(0, cur)) return;
  f32x4 acc[2][2][4][2];
#pragma unroll
  for (int a = 0; a < 2; ++a)
#pragma unroll
    for (int b = 0; b < 2; ++b)
#pragma unroll
      for (int m = 0; m < 4; ++m)
#pragma unroll
        for (int n = 0; n < 2; ++n) acc[a][b][m][n] = (f32x4){0.f, 0.f, 0.f, 0.f};
  bf16x8 At[4][2], B0[2][2], B1[2][2];
  const char* cA = (const char*)g.A + (size_t)cur.pm * tstep + (size_t)cur.k0 * kstep; const char* cB = (const char*)g.Bt + (size_t)cur.pn * tstep + (size_t)cur.k0 * kstep;
  PG8_STAGE(PG8_SB(0, 0), cB, voffB); PG8_STAGE(PG8_SA(0, 0), cA, voffA); PG8_STAGE(PG8_SB(0, 1), cB + hstep, voffB); PG8_STAGE(PG8_SA(0, 1), cA + hstep, voffA);
  if (wr == 1) PG8_BAR;
  PG8_WAIT_V(4); PG8_BAR;
  PG8_STAGE(PG8_SB(1, 0), cB + kstep, voffB); PG8_STAGE(PG8_SA(1, 0), cA + kstep, voffA); PG8_STAGE(PG8_SB(1, 1), cB + hstep + kstep, voffB);
  PG8_WAIT_V(6); PG8_BAR;
  for (;;) {
    const bool has_next = S.next(ui + 1, nxt);
    const char* nA = has_next ? (const char*)g.A + (size_t)nxt.pm * tstep + (size_t)nxt.k0 * kstep : cA; const char* nB = has_next ? (const char*)g.Bt + (size_t)nxt.pn * tstep + (size_t)nxt.k0 * kstep : cB;
    const int nt = cur.nkt;
    for (int t = 0; t < nt; t += 2) {
      const bool last = (t == nt - 2);
      const char* a1 = cA + (size_t)(t + 1) * kstep;
      const char* a2 = last ? nA : cA + (size_t)(t + 2) * kstep; const char* b2 = last ? nB : cB + (size_t)(t + 2) * kstep;
      const char* a3 = a2 + kstep; const char* b3 = b2 + kstep;
      PG8_LDB(B0, 0, 0); PG8_SCHED; PG8_LDA(At, 0, 0); PG8_STAGE(PG8_SA(1, 1), a1 + hstep, voffA);
      PG8_WAIT_L(8); PG8_BAR; PG8_WAIT_L(0); PG8_MMA(0, 0, At, B0); PG8_BAR; PG8_SCHED;
      PG8_LDB(B1, 0, 1); PG8_STAGE(PG8_SB(0, 0), b2, voffB);
      PG8_BAR; PG8_WAIT_L(0); PG8_MMA(0, 1, At, B1); PG8_BAR;
      PG8_LDA(At, 0, 1); PG8_STAGE(PG8_SA(0, 0), a2, voffA);
      PG8_BAR; PG8_WAIT_L(0); PG8_MMA(1, 0, At, B0); PG8_BAR; PG8_SCHED;
      PG8_STAGE(PG8_SB(0, 1), b2 + hstep, voffB);
      PG8_WAIT_V(6); PG8_BAR; PG8_MMA(1, 1, At, B1); PG8_BAR;
      PG8_LDB(B0, 1, 0); PG8_SCHED; PG8_LDA(At, 1, 0); PG8_STAGE(PG8_SA(0, 1), a2 + hstep, voffA);
      PG8_WAIT_L(8); PG8_BAR; PG8_WAIT_L(0); PG8_MMA(0, 0, At, B0); PG8_BAR; PG8_SCHED;
      PG8_LDB(B1, 1, 1); PG8_STAGE(PG8_SB(1, 0), b3, voffB);
      PG8_BAR; PG8_WAIT_L(0); PG8_MMA(0, 1, At, B1); PG8_BAR;
      PG8_LDA(At, 1, 1); PG8_STAGE(PG8_SA(1, 0), a3, voffA);
      PG8_BAR; PG8_WAIT_L(0); PG8_MMA(1, 0, At, B0); PG8_BAR; PG8_SCHED;
      PG8_STAGE(PG8_SB(1, 1), b3 + hstep, voffB);
      PG8_WAIT_V(6); PG8_BAR; PG8_MMA(1, 1, At, B1); PG8_BAR;
    }
    E(acc, cur, wr, wc, fr, fq);
    if (!has_next) break;
#pragma unroll
    for (int a = 0; a < 2; ++a)
#pragma unroll
      for (int b = 0; b < 2; ++b)
#pragma unroll
        for (int m = 0; m < 4; ++m)
#pragma unroll
          for (int n = 0; n < 2; ++n) acc[a][b][m][n] = (f32x4){0.f, 0.f, 0.f, 0.f};
    cur = nxt; cA = nA; cB = nB; ++ui;
  }
  PG8_WAIT_V(0);
  if (wr == 0) PG8_BAR;
  PG8_BAR;
#undef PG8_SA
#undef PG8_SB
#undef PG8_STAGE
#undef PG8_LDA
#undef PG8_LDB
#undef PG8_MMA
}


constexpr int FS_LD = 772;
constexpr int AB_LD = 392;
constexpr int PRM_OFF = 32 * FS_LD * 4 + 32 * AB_LD * 2;
DI float blo(unsigned u) { return __uint_as_float(u << 16); }
DI float bhi(unsigned u) { return __uint_as_float(u & 0xffff0000u); }
DI void rwkv_prep_item(const P& p, int l, int item) {
  float* fs = (float*)smem;
  u16* ab = (u16*)(smem + 32 * FS_LD * 4);
  const int tid = otid();
  const int t0 = item * 32;
  int L, n0;
  if (t0 < TX) { L = 2048; n0 = t0 & 2047; } else { L = 256; n0 = (t0 - TX) & 255; }
  const u16* FR = (const u16*)(p.ws + WS_FR);
  const float* mu0 = p.mu + (size_t)l * 2 * 1152;
  const float* mu1 = mu0 + 1152;
  {
    uint4 fu[9], pu[9], nu[9];
#pragma unroll
    for (int q = 0; q < 9; ++q) {
      const int idx = q * NTHR + tid;
      const int tk = idx / 144, ci = (idx - tk * 144) * 8;
      const int n = n0 + tk;
      const size_t row = (size_t)(t0 + tk);
      fu[q] = *(const uint4*)&FR[row * 1152 + ci];
      pu[q] = *(const uint4*)&FR[(row - (n > 0 ? 1 : 0)) * 1152 + ci];
      nu[q] = *(const uint4*)&FR[(row + (n < L - 1 ? 1 : 0)) * 1152 + ci];
    }
#pragma unroll
    for (int q = 0; q < 9; ++q) {
      const int idx = q * NTHR + tid;
      const int tk = idx / 144, ci = (idx - tk * 144) * 8;
      const int n = n0 + tk;
      const uint4 z4 = make_uint4(0u, 0u, 0u, 0u);
      const uint4 pq = n > 0 ? pu[q] : z4, nq = n < L - 1 ? nu[q] : z4;
      const unsigned fw[4] = {fu[q].x, fu[q].y, fu[q].z, fu[q].w}, pw_[4] = {pq.x, pq.y, pq.z, pq.w}, nw_[4] = {nq.x, nq.y, nq.z, nq.w};
      f32x4 v[2];
#pragma unroll
      for (int hlf = 0; hlf < 2; ++hlf) {
        const f32x4 m0 = *(const f32x4*)&mu0[ci + 4 * hlf], m1 = *(const f32x4*)&mu1[ci + 4 * hlf];
        const f32x4 ff = {blo(fw[2 * hlf]), bhi(fw[2 * hlf]), blo(fw[2 * hlf + 1]), bhi(fw[2 * hlf + 1])};
        const f32x4 pp = {blo(pw_[2 * hlf]), bhi(pw_[2 * hlf]), blo(pw_[2 * hlf + 1]), bhi(pw_[2 * hlf + 1])};
        const f32x4 nn = {blo(nw_[2 * hlf]), bhi(nw_[2 * hlf]), blo(nw_[2 * hlf + 1]), bhi(nw_[2 * hlf + 1])};
        v[hlf] = ff + m0 * (pp - ff) + m1 * (nn - ff);
      }
      if (ci < 768) { *(f32x4*)&fs[tk * FS_LD + ci] = v[0]; *(f32x4*)&fs[tk * FS_LD + ci + 4] = v[1]; }
      else {
        const bool isT = ci < 896, isS = ci >= 1024;
        const float sc = isT ? 2.f : 1.f;
#pragma unroll
        for (int hlf = 0; hlf < 2; ++hlf)
#pragma unroll
          for (int e = 0; e < 4; ++e) { const float y = sigm(sc * v[hlf][e]); v[hlf][e] = isT ? 2.f * y - 1.f : (isS ? y : v[hlf][e]); }
        *(uint4*)&ab[tk * AB_LD + (ci - 768)] = make_uint4(pack2(v[0][0], v[0][1]), pack2(v[0][2], v[0][3]), pack2(v[1][0], v[1][1]), pack2(v[1][2], v[1][3]));
      }
    }
  }
  __syncthreads();
  const int lane = tid & 63, w = tid >> 6, h = w & 3, mt = w >> 2, col = lane & 15, kc = lane >> 4;
  bf16x8 af_[12];
#pragma unroll
  for (int i = 0; i < 12; ++i) af_[i] = *(const bf16x8*)&ab[(mt * 16 + col) * AB_LD + i * 32 + kc * 8];
  const u16* LW = (const u16*)(p.ws + WS_LORA);
  const u16* W2T = LW + (size_t)(l * 2) * 256 * 64;
  const u16* A2T = LW + 65536 + (size_t)(l * 2) * 256 * 64;
  const u16* G2T = LW + 131072 + (size_t)l * 256 * 128;
  const int tk = mt * 16 + col;
  const float* fr_ = fs + tk * FS_LD;
  float rsq = 0.f;
#pragma unroll
  for (int nt = 0; nt < 4; ++nt) {
    const int c4 = h * 64 + nt * 16 + kc * 4;
    const float4 kv = *(const float4*)&fr_[256 + c4];
    const float4 ks4 = *(const float4*)&((const float*)(smem + PRM_OFF))[4 * 256 + c4];
    const float q0 = kv.x * ks4.x, q1 = kv.y * ks4.y, q2 = kv.z * ks4.z, q3 = kv.w * ks4.w;
    rsq += q0 * q0 + q1 * q1 + q2 * q2 + q3 * q3;
  }
  rsq += __shfl_xor(rsq, 16); rsq += __shfl_xor(rsq, 32);
  const float rs = rsqrtf(rsq + 1e-12f);
  float bsp = 0.f;
  u16* SC = (u16*)(p.ws + WS_SC);
  u16* Gp = (u16*)(p.ws + WS_G);
  u16* BON = (u16*)(p.ws + WS_BON);
  constexpr size_t AS = (size_t)T * 256;
  bf16x8 wq[2][12];
#define LOADW(buf, nt_) do { const int ca_ = h * 64 + ((nt_) >> 1) * 32 + (col >> 2) * 8 + ((nt_) & 1) * 4 + (col & 3);     \
    _Pragma("unroll") for (int ks = 0; ks < 2; ++ks) { \
      wq[buf][0 + ks] = *(const bf16x8*)&W2T[(size_t)ca_ * 64 + ks * 32 + kc * 8]; \
      wq[buf][2 + ks] = *(const bf16x8*)&W2T[(size_t)(256 + ca_) * 64 + ks * 32 + kc * 8]; \
      wq[buf][4 + ks] = *(const bf16x8*)&A2T[(size_t)ca_ * 64 + ks * 32 + kc * 8]; \
      wq[buf][6 + ks] = *(const bf16x8*)&A2T[(size_t)(256 + ca_) * 64 + ks * 32 + kc * 8]; } \
    _Pragma("unroll") for (int ks = 0; ks < 4; ++ks) wq[buf][8 + ks] = *(const bf16x8*)&G2T[(size_t)ca_ * 128 + ks * 32 + kc * 8]; } while (0)
  uint2 lo_[10];
  LOADW(0, 0);
#pragma unroll
  for (int nt = 0; nt < 4; ++nt) {
    if (nt + 1 < 4) LOADW((nt + 1) & 1, nt + 1);
    const int c4 = h * 64 + (nt >> 1) * 32 + kc * 8 + (nt & 1) * 4;
    f32x4 cwf = {0.f, 0.f, 0.f, 0.f}, cwb = cwf, caf = cwf, cab = cwf, cg = cwf;
#pragma unroll
    for (int ks = 0; ks < 2; ++ks) {
      cwf = __builtin_amdgcn_mfma_f32_16x16x32_bf16(wq[nt & 1][0 + ks], af_[0 + ks], cwf, 0, 0, 0);
      cwb = __builtin_amdgcn_mfma_f32_16x16x32_bf16(wq[nt & 1][2 + ks], af_[2 + ks], cwb, 0, 0, 0);
      caf = __builtin_amdgcn_mfma_f32_16x16x32_bf16(wq[nt & 1][4 + ks], af_[4 + ks], caf, 0, 0, 0);
      cab = __builtin_amdgcn_mfma_f32_16x16x32_bf16(wq[nt & 1][6 + ks], af_[6 + ks], cab, 0, 0, 0);
    }
#pragma unroll
    for (int ks = 0; ks < 4; ++ks) cg = __builtin_amdgcn_mfma_f32_16x16x32_bf16(wq[nt & 1][8 + ks], af_[8 + ks], cg, 0, 0, 0);
    const float* prm = (const float*)(smem + PRM_OFF);
    const f32x4 w0f = *(const f32x4*)&prm[0 * 256 + c4], w0b = *(const f32x4*)&prm[1 * 256 + c4];
    const f32x4 a0f = *(const f32x4*)&prm[2 * 256 + c4], a0b = *(const f32x4*)&prm[3 * 256 + c4];
    const f32x4 kks = *(const f32x4*)&prm[4 * 256 + c4], kas = *(const f32x4*)&prm[5 * 256 + c4], rkc = *(const f32x4*)&prm[6 * 256 + c4];
    const f32x4 r4 = *(const f32x4*)&fr_[c4], k4 = *(const f32x4*)&fr_[256 + c4], v4 = *(const f32x4*)&fr_[512 + c4];
    float o_r[4], o_v[4], o_a[4], o_w0[4], o_w1[4], o_k0[4], o_k1[4], o_b0[4], o_b1[4], o_g[4];
#pragma unroll
    for (int j = 0; j < 4; ++j) {
      const float r = r4[j], k = k4[j], v = v4[j];
      const float sd0 = 0.6065306597126334f * sigm(w0f[j] + cwf[j]);
      const float sd1 = 0.6065306597126334f * sigm(w0b[j] + cwb[j]);
      const float a0 = sigm(a0f[j] + caf[j]), a1 = sigm(a0b[j] + cab[j]);
      const float kkn = k * kks[j] * rs;
      const float k0 = k * (1.f + (a0 - 1.f) * kas[j]), k1 = k * (1.f + (a1 - 1.f) * kas[j]);
      bsp += r * (k0 + k1) * rkc[j];
      o_r[j] = r; o_v[j] = v; o_a[j] = -kkn; o_w0[j] = sd0; o_w1[j] = sd1; o_k0[j] = k0; o_k1[j] = k1; o_b0[j] = kkn * a0; o_b1[j] = kkn * a1; o_g[j] = cg[j];
    }
#define PK4(a_) make_uint2(pack2(a_[0], a_[1]), pack2(a_[2], a_[3]))
    if ((nt & 1) == 0) {
      lo_[0] = PK4(o_r); lo_[1] = PK4(o_v); lo_[2] = PK4(o_a); lo_[3] = PK4(o_w0); lo_[4] = PK4(o_w1);
      lo_[5] = PK4(o_k0); lo_[6] = PK4(o_k1); lo_[7] = PK4(o_b0); lo_[8] = PK4(o_b1); lo_[9] = PK4(o_g);
    } else {
      const size_t o = (size_t)(t0 + tk) * 256 + h * 64 + (nt >> 1) * 32 + kc * 8;
#define ST8(dst, a_, li) do { const uint2 hi_ = PK4(a_); *(uint4*)&(dst)[o] = make_uint4(lo_[li].x, lo_[li].y, hi_.x, hi_.y); } while (0)
      ST8(SC + 0 * AS, o_r, 0); ST8(SC + 1 * AS, o_v, 1); ST8(SC + 2 * AS, o_a, 2); ST8(SC + 3 * AS, o_w0, 3); ST8(SC + 4 * AS, o_w1, 4);
      ST8(SC + 5 * AS, o_k0, 5); ST8(SC + 6 * AS, o_k1, 6); ST8(SC + 7 * AS, o_b0, 7); ST8(SC + 8 * AS, o_b1, 8); ST8(Gp, o_g, 9);
#undef ST8
    }
  }
  bsp += __shfl_xor(bsp, 16); bsp += __shfl_xor(bsp, 32);
#pragma unroll
  for (int pp = 0; pp < 2; ++pp) {
    const int c8 = h * 64 + pp * 32 + kc * 8;
    const f32x4 va = *(const f32x4*)&fr_[512 + c8], vb = *(const f32x4*)&fr_[512 + c8 + 4];
    float oa[4], ob2[4];
#pragma unroll
    for (int j = 0; j < 4; ++j) { oa[j] = bsp * va[j]; ob2[j] = bsp * vb[j]; }
    const uint2 l2 = PK4(oa), h2 = PK4(ob2);
    *(uint4*)&BON[(size_t)(t0 + tk) * 256 + c8] = make_uint4(l2.x, l2.y, h2.x, h2.y);
  }
#undef PK4
#undef LOADW
  __syncthreads();
}

DI void conv_item(const P& p, int l, int item, const float (&wreg)[31], const float bias) {
  float* hb = (float*)smem;
  float* ob = hb + 62 * 256;
  const int tid = otid();
  const int t0 = item * 32;
  int L, n0;
  if (t0 < TX) { L = 2048; n0 = t0 & 2047; } else { L = 256; n0 = (t0 - TX) & 255; }
  const u16* FC = (const u16*)(p.ws + WS_FC);
  const int c = tid & 255, ph = tid >> 8;
  {
    uint4 vv_[4], gg_[4];
#pragma unroll
    for (int q = 0; q < 4; ++q) {
      const int idx = q * NTHR + tid;
      const int rr = idx >> 5, cq = (idx & 31) * 8;
      const int n = n0 + rr - 15;
      const bool ok = rr < 62 && n >= 0 && n < L;
      const size_t row = ok ? (size_t)(t0 + rr - 15) : (size_t)t0;
      vv_[q] = *(const uint4*)&FC[row * 512 + cq]; gg_[q] = *(const uint4*)&FC[row * 512 + 256 + cq];
    }
#pragma unroll
    for (int q = 0; q < 4; ++q) {
      const int idx = q * NTHR + tid;
      const int rr = idx >> 5, cq = (idx & 31) * 8;
      const int n = n0 + rr - 15;
      const bool ok = n >= 0 && n < L;
      const unsigned vw[4] = {vv_[q].x, vv_[q].y, vv_[q].z, vv_[q].w}, gw[4] = {gg_[q].x, gg_[q].y, gg_[q].z, gg_[q].w};
      f32x4 h0 = {0.f, 0.f, 0.f, 0.f}, h1 = h0;
      if (ok) {
        h0[0] = blo(vw[0]) * sigm(blo(gw[0])); h0[1] = bhi(vw[0]) * sigm(bhi(gw[0])); h0[2] = blo(vw[1]) * sigm(blo(gw[1])); h0[3] = bhi(vw[1]) * sigm(bhi(gw[1]));
        h1[0] = blo(vw[2]) * sigm(blo(gw[2])); h1[1] = bhi(vw[2]) * sigm(bhi(gw[2])); h1[2] = blo(vw[3]) * sigm(blo(gw[3])); h1[3] = bhi(vw[3]) * sigm(bhi(gw[3]));
      }
      if (rr < 62) { *(f32x4*)&hb[rr * 256 + cq] = h0; *(f32x4*)&hb[rr * 256 + cq + 4] = h1; }
    }
  }
  __syncthreads();
  {
    for (int pp = 0; pp < 16; ++pp) {
      const int pos = ph * 16 + pp;
      float a = bias;
#pragma unroll
      for (int w = 0; w < 31; ++w) a += hb[(pos + w) * 256 + c] * wreg[w];
      ob[pos * 256 + c] = a;
    }
  }
  __syncthreads();
  {
    const int lane = tid & 63, w = tid >> 6;
    u16* CAT = (u16*)(p.ws + WS_H);
    const float4 g4 = *(const float4*)&p.cln_g[l * 256 + lane * 4];
    const float4 b4 = *(const float4*)&p.cln_b[l * 256 + lane * 4];
#pragma unroll
    for (int q = 0; q < 4; ++q) {
      const int pos = w * 4 + q;
      const float4 v = *(const float4*)&ob[pos * 256 + lane * 4];
      const float mu = wave_sum(v.x + v.y + v.z + v.w) * (1.f / 256.f);
      const float d0 = v.x - mu, d1 = v.y - mu, d2 = v.z - mu, d3 = v.w - mu;
      const float var = wave_sum(d0 * d0 + d1 * d1 + d2 * d2 + d3 * d3) * (1.f / 256.f);
      const float rs = rsqrtf(var + 1e-5f);
      float y0 = d0 * rs * g4.x + b4.x, y1 = d1 * rs * g4.y + b4.y, y2 = d2 * rs * g4.z + b4.z, y3 = d3 * rs * g4.w + b4.w;
      y0 *= sigm(y0); y1 *= sigm(y1); y2 *= sigm(y2); y3 *= sigm(y3);
      uint2 o; o.x = pack2(y0, y1); o.y = pack2(y2, y3);
      *(uint2*)&CAT[(size_t)(t0 + pos) * 1024 + 256 + lane * 4] = o;
    }
  }
  __syncthreads();
}

DI void prepconv_phase(const P& p, int l, int rep) {
  const int nprep = T / 32, nconv = (l == 0 ? T : TX) / 32;
  unsigned* ctr = (unsigned*)(p.ws + WS_MISC) + 12 + l + 2 * rep;
  int* slot = (int*)(smem + LDS_CTL);
  {
    float* prm = (float*)(smem + PRM_OFF);
    for (int i = otid(); i < 7 * 256; i += NTHR) {
      const int a = i >> 8, c = i & 255;
      prm[i] = a < 2 ? p.w0[(l * 2 + a) * 256 + c] : a < 4 ? p.a0[(l * 2 + (a - 2)) * 256 + c] : a == 4 ? p.kk[l * 256 + c] : a == 5 ? p.ka[l * 256 + c] : p.rk[l * 256 + c];
    }
    __syncthreads();
  }
  int it = obid();
  while (it < nprep) {
    unsigned nx = 0u;
    if (otid() == 0) nx = atomicAdd(ctr, 1u);
    if (!(rep && MIXPROBE == 4)) rwkv_prep_item(p, l, it);
    if (otid() == 0) *slot = (int)(gridDim.x + nx);
    __syncthreads();
    it = *slot;
    __syncthreads();
  }
  {
    unsigned* ctr2 = (unsigned*)(p.ws + WS_MISC) + 16 + l + 2 * rep;
    const int c = otid() & 255;
    float wreg[31];
#pragma unroll
    for (int w = 0; w < 31; ++w) wreg[w] = p.dw_w[(size_t)(l * 31 + w) * 256 + c];
    const float bias = p.dw_b[l * 256 + c];
    it = obid();
    while (it < nconv) {
      unsigned nx = 0u;
      if (otid() == 0) nx = atomicAdd(ctr2, 1u);
      if (!(rep && MIXPROBE == 3)) conv_item(p, l, it, wreg, bias);
      if (otid() == 0) *slot = (int)(gridDim.x + nx);
      __syncthreads();
      it = *slot;
      __syncthreads();
    }
  }
}

DI int scan_row(int b, int dir, int gs) {
  if (dir == 0) return gs < 256 ? TX + b * 256 + gs : b * 2048 + (gs - 256);
  return gs < 256 ? TX + b * 256 + (255 - gs) : b * 2048 + (2047 - (gs - 256));
}

DI float allred8(float v) {
  v += dppx<0xB1>(v); v += dppx<0x4E>(v); v += dppx<0x141>(v);
  return v;
}
typedef float f2 __attribute__((ext_vector_type(2)));
constexpr int SST = 320;
constexpr int SOFF_V = 16 * SST;
constexpr int SOFF_BK = SOFF_V + 512;
constexpr int SBUF = SOFF_BK + 64;
struct ScanStep { f2 a[4], w[4], r[4], b[4], k[4]; };
DI void scan_block(const P& p, int sb) {
  const int tid = otid();
  const int chain = sb >> 1, rh = sb & 1, b = chain >> 3, h = (chain >> 1) & 3, dir = chain & 1;
  float* stg = (float*)smem;
  float* ybuf = stg + 2 * SBUF;
  const u16* SC = (const u16*)(p.ws + WS_SC);
  constexpr size_t AS = (size_t)T * 256;
  const bool is_comp = tid < 256;
#define LO(u) __uint_as_float((u) << 16)
#define HI(u) __uint_as_float((u) & 0xffff0000u)
  if (is_comp) {
    const int lane = tid & 63, cw = tid >> 6, jg = lane & 7, rl = cw * 8 + (lane >> 3);
    f2 S[4];
#pragma unroll
    for (int i = 0; i < 4; ++i) S[i] = (f2){0.f, 0.f};
    __syncthreads();
    for (int ch = 0; ch < 144; ++ch) {
      const float* st = stg + (ch & 1) * SBUF;
      float* yb = (jg == 0) ? (ybuf + (ch & 1) * 512 + rl) : (ybuf + 1024 + tid);
#define SLD(R, s) do { const float* d_ = st + (s) * SST + jg * 8; \
      { const float4 x_ = *(const float4*)&d_[0], y_ = *(const float4*)&d_[4]; R.a[0] = (f2){x_.x, x_.y}; R.a[1] = (f2){x_.z, x_.w}; R.a[2] = (f2){y_.x, y_.y}; R.a[3] = (f2){y_.z, y_.w}; } \
      { const float4 x_ = *(const float4*)&d_[64], y_ = *(const float4*)&d_[68]; R.w[0] = (f2){x_.x, x_.y}; R.w[1] = (f2){x_.z, x_.w}; R.w[2] = (f2){y_.x, y_.y}; R.w[3] = (f2){y_.z, y_.w}; } \
      { const float4 x_ = *(const float4*)&d_[128], y_ = *(const float4*)&d_[132]; R.r[0] = (f2){x_.x, x_.y}; R.r[1] = (f2){x_.z, x_.w}; R.r[2] = (f2){y_.x, y_.y}; R.r[3] = (f2){y_.z, y_.w}; } \
      { const float4 x_ = *(const float4*)&d_[192], y_ = *(const float4*)&d_[196]; R.b[0] = (f2){x_.x, x_.y}; R.b[1] = (f2){x_.z, x_.w}; R.b[2] = (f2){y_.x, y_.y}; R.b[3] = (f2){y_.z, y_.w}; } \
      { const float4 x_ = *(const float4*)&d_[256], y_ = *(const float4*)&d_[260]; R.k[0] = (f2){x_.x, x_.y}; R.k[1] = (f2){x_.z, x_.w}; R.k[2] = (f2){y_.x, y_.y}; R.k[3] = (f2){y_.z, y_.w}; } } while (0)
      float vv[16]; float bk[32];
#pragma unroll
      for (int q = 0; q < 4; ++q) { const float4 x_ = *(const float4*)&st[SOFF_V + rl * 16 + q * 4]; vv[q * 4] = x_.x; vv[q * 4 + 1] = x_.y; vv[q * 4 + 2] = x_.z; vv[q * 4 + 3] = x_.w; }
#pragma unroll
      for (int q = 0; q < 8; ++q) { const float4 x_ = *(const float4*)&st[SOFF_BK + q * 4]; bk[q * 4] = x_.x; bk[q * 4 + 1] = x_.y; bk[q * 4 + 2] = x_.z; bk[q * 4 + 3] = x_.w; }
      ScanStep cur, nxt;
      SLD(cur, 0);
#pragma unroll
      for (int s = 0; s < 16; ++s) {
        if (s + 1 < 16) SLD(nxt, s + 1);
        __builtin_amdgcn_sched_barrier(0);
        f2 t = S[0] * cur.a[0]; t = S[1] * cur.a[1] + t; t = S[2] * cur.a[2] + t; t = S[3] * cur.a[3] + t;
        f2 u = S[0] * cur.r[0]; u = S[1] * cur.r[1] + u; u = S[2] * cur.r[2] + u; u = S[3] * cur.r[3] + u;
        float sa = t.x + t.y, yp = u.x + u.y;
        sa = allred8(sa);
        yp = allred8(yp);
        const float v = vv[s];
        const float y = yp + sa * bk[2 * s] + v * bk[2 * s + 1];
        const f2 sa2 = (f2){sa, sa}, v2 = (f2){v, v};
#pragma unroll
        for (int i = 0; i < 4; ++i) S[i] = S[i] * cur.w[i] + (sa2 * cur.b[i] + v2 * cur.k[i]);
        yb[s * 32] = y;
        if (s + 1 < 16) cur = nxt;
      }
#undef SLD
      __syncthreads();
    }
    __syncthreads();
  } else {
    const int t2 = tid - 256, s_ = t2 >> 4, q_ = t2 & 15;
    const u16* Rp = SC, *Vp = SC + AS, *Ap = SC + 2 * AS, *Wp = SC + (3 + dir) * AS, *Kp = SC + (5 + dir) * AS, *Bp = SC + (7 + dir) * AS;
    u16* Y = (u16*)(p.ws + WS_Y) + (size_t)dir * AS;
    const int choff = h * 64 + 4 * q_;
    uint2 prA, pvA, paA, pwA, pkA, pbA, prB, pvB, paB, pwB, pkB, pbB;
#define SCAN_ISSUE(X, ch) do { const size_t o_ = (size_t)scan_row(b, dir, (ch) * 16 + s_) * 256 + choff; \
    pr##X = *(const uint2*)&Rp[o_]; pv##X = *(const uint2*)&Vp[o_]; pa##X = *(const uint2*)&Ap[o_]; \
    pw##X = *(const uint2*)&Wp[o_]; pk##X = *(const uint2*)&Kp[o_]; pb##X = *(const uint2*)&Bp[o_]; } while (0)
#define SCAN_COMMIT(X, bufi) do { float* d0_ = stg + (bufi) * SBUF; float* d_ = d0_ + s_ * SST; \
    const float4 r4 = make_float4(LO(pr##X.x), HI(pr##X.x), LO(pr##X.y), HI(pr##X.y)); \
    const float4 w4 = make_float4(__expf(-LO(pw##X.x)), __expf(-HI(pw##X.x)), __expf(-LO(pw##X.y)), __expf(-HI(pw##X.y))); \
    const float4 k4 = make_float4(LO(pk##X.x), HI(pk##X.x), LO(pk##X.y), HI(pk##X.y)); \
    const float4 b4 = make_float4(LO(pb##X.x), HI(pb##X.x), LO(pb##X.y), HI(pb##X.y)); \
    *(float4*)&d_[4 * q_] = make_float4(LO(pa##X.x), HI(pa##X.x), LO(pa##X.y), HI(pa##X.y)); \
    *(float4*)&d_[64 + 4 * q_] = w4; \
    *(float4*)&d_[128 + 4 * q_] = make_float4(w4.x * r4.x, w4.y * r4.y, w4.z * r4.z, w4.w * r4.w); \
    *(float4*)&d_[192 + 4 * q_] = b4; \
    *(float4*)&d_[256 + 4 * q_] = k4; \
    if ((q_ >> 3) == rh) { float* dv_ = d0_ + SOFF_V + 4 * (q_ & 7) * 16 + s_; dv_[0] = LO(pv##X.x); dv_[16] = HI(pv##X.x); dv_[32] = LO(pv##X.y); dv_[48] = HI(pv##X.y); } \
    float br_ = b4.x * r4.x + b4.y * r4.y + b4.z * r4.z + b4.w * r4.w; \
    float kr_ = k4.x * r4.x + k4.y * r4.y + k4.z * r4.z + k4.w * r4.w; \
    br_ = allred16(br_); kr_ = allred16(kr_); \
    if (q_ == 0) *(float2*)&d0_[SOFF_BK + 2 * s_] = make_float2(br_, kr_); } while (0)
#define SCAN_YSTORE(ch) do { const float* yb_ = ybuf + ((ch) & 1) * 512; \
    const float2 yv_ = *(const float2*)&yb_[s_ * 32 + 2 * q_]; \
    const int row_ = scan_row(b, dir, (ch) * 16 + s_); \
    *(unsigned*)&Y[(size_t)row_ * 256 + h * 64 + rh * 32 + 2 * q_] = pack2(yv_.x, yv_.y); } while (0)
    SCAN_ISSUE(A, 0);
    SCAN_COMMIT(A, 0);
    SCAN_ISSUE(B, 1);
    __syncthreads();
    for (int ch = 0; ch < 144; ch += 2) {
      SCAN_COMMIT(B, 1);
      if (ch + 2 < 144) SCAN_ISSUE(A, ch + 2);
      if (ch > 0) SCAN_YSTORE(ch - 1);
      __syncthreads();
      if (ch + 2 < 144) SCAN_COMMIT(A, 0);
      if (ch + 3 < 144) SCAN_ISSUE(B, ch + 3);
      SCAN_YSTORE(ch);
      __syncthreads();
    }
    SCAN_YSTORE(143);
    __syncthreads();
#undef SCAN_ISSUE
#undef SCAN_COMMIT
#undef SCAN_YSTORE
  }
}

#define MFMA32(a, b, c) __builtin_amdgcn_mfma_f32_32x32x16_bf16((a), (b), (c), 0, 0, 0)
constexpr int ATT_BUF = 36864;
DI void attn_item(const P& p, int l, int item) {
  const int tid = otid(), lane = tid & 63, wave = tid >> 6, m = wave >> 2, qw = wave & 3, r = lane & 31, hh = lane >> 5;
  int qrow0, b, h, key0, nk;
  if (item < 512) { b = item >> 6; h = (item >> 4) & 3; qrow0 = b * 2048 + (item & 15) * 128; key0 = 0; nk = 2304; }
  else { const int it = item - 512; b = it >> 3; h = (it >> 1) & 3; qrow0 = TX + b * 256 + (it & 1) * 128; key0 = 2048; nk = 256; }
  const u16* Q = (const u16*)(p.ws + WS_Q);
  const u16* KK = (const u16*)(p.ws + WS_KK) + ((size_t)b * 2304 + key0) * 512 + h * 128;
  const u16* VT = (const u16*)(p.ws + WS_VT) + ((size_t)(b * 4 + h) * 128) * 2304 + key0;
  bf16x8 qf[4];
  {
    const u16* qp = Q + (size_t)(qrow0 + qw * 32 + r) * 512 + h * 128 + m * 64 + hh * 8;
#pragma unroll
    for (int ks = 0; ks < 4; ++ks) qf[ks] = *(const bf16x8*)&qp[ks * 16];
  }
  uint4 g0 = make_uint4(0u, 0u, 0u, 0u), g1 = g0, g2 = g0, g3 = g0;
  const int ck0 = tid, ck1 = tid + 512;
  const int kdst0 = (ck0 >> 9) * 9216 + ((ck0 >> 3) & 63) * 144 + (ck0 & 7) * 16;
  const int kdst1 = (ck1 >> 9) * 9216 + ((ck1 >> 3) & 63) * 144 + (ck1 & 7) * 16;
  const size_t ksrc0 = (size_t)((ck0 >> 3) & 63) * 512 + (ck0 >> 9) * 64 + (ck0 & 7) * 8;
  const size_t ksrc1 = (size_t)((ck1 >> 3) & 63) * 512 + (ck1 >> 9) * 64 + (ck1 & 7) * 8;
  const int vdst0 = 18432 + (ck0 >> 3) * 144 + (ck0 & 7) * 16;
  const int vdst1 = 18432 + (ck1 >> 3) * 144 + (ck1 & 7) * 16;
  const size_t vsrc0 = (size_t)(ck0 >> 3) * 2304 + (ck0 & 7) * 8;
  const size_t vsrc1 = (size_t)(ck1 >> 3) * 2304 + (ck1 & 7) * 8;
#define ATT_LOAD(t) do { const u16* kp_ = KK + (size_t)(t) * 64 * 512; const u16* vp_ = VT + (t) * 64; \
    g0 = *(const uint4*)&kp_[ksrc0]; g1 = *(const uint4*)&kp_[ksrc1]; \
    g2 = *(const uint4*)&vp_[vsrc0]; g3 = *(const uint4*)&vp_[vsrc1]; } while (0)
#define ATT_STORE(bi) do { unsigned char* bb_ = smem + (bi) * ATT_BUF; \
    *(uint4*)(bb_ + kdst0) = g0; *(uint4*)(bb_ + kdst1) = g1; \
    *(uint4*)(bb_ + vdst0) = g2; *(uint4*)(bb_ + vdst1) = g3; } while (0)
#define ATT_QK(kb) do { _Pragma("unroll") for (int ks = 0; ks < 4; ++ks) { \
      const bf16x8 a0_ = *(const bf16x8*)((kb) + r * 144 + ks * 32 + hh * 16); \
      const bf16x8 a1_ = *(const bf16x8*)((kb) + (32 + r) * 144 + ks * 32 + hh * 16); \
      s0 = MFMA32(a0_, qf[ks], s0); s1 = MFMA32(a1_, qf[ks], s1); } } while (0)
#define ATT_PV1(vb, kt, s, PF) do { _Pragma("unroll") for (int nt = 0; nt < 4; ++nt) { \
        const unsigned char* vp_ = (vb) + (nt * 32 + r) * 144 + ((kt) * 32 + 16 * (s) + 4 * hh) * 2; \
        const s16x4 lo_ = *(const s16x4*)vp_; const s16x4 hi_ = *(const s16x4*)(vp_ + 16); \
        const bf16x8 vf_ = __builtin_shufflevector(lo_, hi_, 0, 1, 2, 3, 4, 5, 6, 7); \
        o[nt] = MFMA32(vf_, PF, o[nt]); } } while (0)
#define ATT_PV(vb) do { ATT_PV1(vb, 0, 0, pf0); ATT_PV1(vb, 0, 1, pf1); ATT_PV1(vb, 1, 0, pf2); ATT_PV1(vb, 1, 1, pf3); } while (0)
  const int ntile = nk / 64;
  ATT_LOAD(0);
  ATT_STORE(0);
  __syncthreads();
  float mrun;
  {
    f32x16 s0, s1;
#pragma unroll
    for (int j = 0; j < 16; ++j) { s0[j] = 0.f; s1[j] = 0.f; }
    const unsigned char* kb = smem + m * 9216;
    ATT_QK(kb);
    float mx = s0[0];
#pragma unroll
    for (int j = 1; j < 16; ++j) mx = fmaxf(mx, s0[j]);
#pragma unroll
    for (int j = 0; j < 16; ++j) mx = fmaxf(mx, s1[j]);
    mrun = fmaxf(mx, __shfl_xor(mx, 32));
  }
  f32x16 o[4];
#pragma unroll
  for (int i = 0; i < 4; ++i)
#pragma unroll
    for (int j = 0; j < 16; ++j) o[i][j] = 0.f;
  float lrun = 0.f;
  bf16x8 pf0, pf1, pf2, pf3;
#pragma unroll
  for (int j = 0; j < 8; ++j) { pf0[j] = 0; pf1[j] = 0; pf2[j] = 0; pf3[j] = 0; }
  for (int t = 0; t <= ntile; ++t) {
    if (t + 1 < ntile) ATT_LOAD(t + 1);
    if (m == 1 && t > 0) { const unsigned char* vb = smem + ((t - 1) % 3) * ATT_BUF + 18432; ATT_PV(vb); }
    if (t < ntile) {
      const unsigned char* kb = smem + (t % 3) * ATT_BUF + m * 9216;
      f32x16 s0, s1;
      const float nm = -mrun;
#pragma unroll
      for (int j = 0; j < 16; ++j) { s0[j] = nm; s1[j] = nm; }
      ATT_QK(kb);
      float mx = s0[0];
#pragma unroll
      for (int j = 1; j < 16; ++j) mx = fmaxf(mx, s0[j]);
#pragma unroll
      for (int j = 0; j < 16; ++j) mx = fmaxf(mx, s1[j]);
      if (__builtin_amdgcn_ballot_w64(mx > 8.f) != 0ull) {
        const float mo = fmaxf(mx, __shfl_xor(mx, 32));
        const float delta = fmaxf(mo, 0.f);
        const float alpha = __builtin_amdgcn_exp2f(-delta);
        mrun += delta; lrun *= alpha;
#pragma unroll
        for (int i = 0; i < 4; ++i)
#pragma unroll
          for (int j = 0; j < 16; ++j) o[i][j] *= alpha;
#pragma unroll
        for (int j = 0; j < 16; ++j) { s0[j] -= delta; s1[j] -= delta; }
      }
      float ls = 0.f;
#pragma unroll
      for (int j = 0; j < 16; ++j) { s0[j] = __builtin_amdgcn_exp2f(s0[j]); ls += s0[j]; }
#pragma unroll
      for (int j = 0; j < 16; ++j) { s1[j] = __builtin_amdgcn_exp2f(s1[j]); ls += s1[j]; }
      lrun += ls;
#pragma unroll
      for (int j = 0; j < 8; ++j) { pf0[j] = (short)f2bf(s0[j]); pf1[j] = (short)f2bf(s0[8 + j]); pf2[j] = (short)f2bf(s1[j]); pf3[j] = (short)f2bf(s1[8 + j]); }
    }
    if (m == 0 && t < ntile) { const unsigned char* vb = smem + (t % 3) * ATT_BUF + 18432; ATT_PV(vb); }
    if (t + 1 < ntile) ATT_STORE((t + 1) % 3);
    __syncthreads();
  }
  const float lt = lrun + __shfl_xor(lrun, 32);
  const float inv = 1.f / lt;
  float* ob = (float*)smem;
  if (m == 1) {
#pragma unroll
    for (int nt = 0; nt < 4; ++nt)
#pragma unroll
      for (int j = 0; j < 16; ++j) ob[((qw * 4 + nt) * 16 + j) * 64 + lane] = o[nt][j] * inv;
  }
  __syncthreads();
  if (m == 0) {
    const float* mf = (const float*)(p.ws + WS_MISC);
    const float lamv = mf[l], li = mf[2 + l];
    float ss = 0.f;
#pragma unroll
    for (int nt = 0; nt < 4; ++nt)
#pragma unroll
      for (int j = 0; j < 16; ++j) {
        const float dv = o[nt][j] * inv - lamv * ob[((qw * 4 + nt) * 16 + j) * 64 + lane];
        o[nt][j] = dv;
        ss += dv * dv;
      }
    ss += __shfl_xor(ss, 32);
    const float rs = rsqrtf(ss * (1.f / 128.f) + 1e-5f) * (1.f - li);
    u16* CAT = (u16*)(p.ws + WS_H) + (size_t)(qrow0 + qw * 32 + r) * 1024 + 512 + h * 128;
    const float* gp = p.dng + l * 128;
#pragma unroll
    for (int nt = 0; nt < 4; ++nt) {
      uint2 ch[4];
#pragma unroll
      for (int g = 0; g < 4; ++g) {
        const int vd = nt * 32 + 8 * g + 4 * hh;
        const float4 g4 = *(const float4*)&gp[vd];
        ch[g].x = pack2(o[nt][4 * g + 0] * rs * g4.x, o[nt][4 * g + 1] * rs * g4.y);
        ch[g].y = pack2(o[nt][4 * g + 2] * rs * g4.z, o[nt][4 * g + 3] * rs * g4.w);
      }
#pragma unroll
      for (int q = 0; q < 2; ++q) {
        const uint2 snd = hh ? ch[2 * q] : ch[2 * q + 1];
        const uint2 rcv = make_uint2((unsigned)__shfl_xor((int)snd.x, 32), (unsigned)__shfl_xor((int)snd.y, 32));
        const uint4 o4 = hh ? make_uint4(rcv.x, rcv.y, ch[2 * q + 1].x, ch[2 * q + 1].y) : make_uint4(ch[2 * q].x, ch[2 * q].y, rcv.x, rcv.y);
        *(uint4*)&CAT[nt * 32 + 16 * q + 8 * hh] = o4;
      }
    }
  }
  __syncthreads();
#undef ATT_LOAD
#undef ATT_STORE
#undef ATT_QK
#undef ATT_PV
#undef ATT_PV1
}

DI void mixer_phase(const P& p, int l, int rep) {
  if (!(rep && MIXPROBE == 1)) for (int sb = obid(); sb < 128; sb += gridDim.x) scan_block(p, sb);
  if (rep && MIXPROBE == 2) return;
  const int nitems = l == 0 ? 576 : 512;
  unsigned* ctr = (unsigned*)(p.ws + WS_MISC) + 8 + l + 2 * rep;
  int* slot = (int*)(smem + LDS_CTL);
  const int nstat = (int)gridDim.x > 128 ? (int)gridDim.x - 128 : 0;
  int it;
  if (obid() >= 128) it = obid() - 128;
  else {
    if (otid() == 0) *slot = nstat + (int)atomicAdd(ctr, 1u);
    __syncthreads();
    it = *slot;
    __syncthreads();
  }
  while (it < nitems) {
    unsigned nx = 0u;
    if (otid() == 0) nx = atomicAdd(ctr, 1u);
    attn_item(p, l, it);
    if (otid() == 0) *slot = nstat + (int)nx;
    __syncthreads();
    it = *slot;
    __syncthreads();
  }
}

DI void finish_phase(const P& p, int l, int rows) {
  const int lane = otid() & 63, w = otid() >> 6, rsel = lane >> 5, l32 = lane & 31;
  const u16* Y = (const u16*)(p.ws + WS_Y);
  const u16* Gp = (const u16*)(p.ws + WS_G);
  const u16* BON = (const u16*)(p.ws + WS_BON);
  u16* CAT = (u16*)(p.ws + WS_H);
  constexpr size_t AS = (size_t)T * 256;
  const f32x4 ga = *(const f32x4*)&p.ln_g[l * 256 + l32 * 8], gb = *(const f32x4*)&p.ln_g[l * 256 + l32 * 8 + 4];
  const f32x4 ba = *(const f32x4*)&p.ln_b[l * 256 + l32 * 8], bb = *(const f32x4*)&p.ln_b[l * 256 + l32 * 8 + 4];
  for (int row = (obid() * 8 + w) * 2 + rsel; row < rows; row += gridDim.x * 16) {
    const size_t o = (size_t)row * 256 + l32 * 8;
    const uint4 yf = *(const uint4*)&Y[o], yb = *(const uint4*)&Y[AS + o];
    const uint4 gg = *(const uint4*)&Gp[o], bo = *(const uint4*)&BON[o];
    const unsigned yfw[4] = {yf.x, yf.y, yf.z, yf.w}, ybw[4] = {yb.x, yb.y, yb.z, yb.w}, ggw[4] = {gg.x, gg.y, gg.z, gg.w}, bow[4] = {bo.x, bo.y, bo.z, bo.w};
    float y[8];
    float s = 0.f;
#pragma unroll
    for (int q = 0; q < 4; ++q) { y[2 * q] = LO(yfw[q]) + LO(ybw[q]); y[2 * q + 1] = HI(yfw[q]) + HI(ybw[q]); s += y[2 * q] + y[2 * q + 1]; }
    s = allred8(s);
    const float mu = s * (1.f / 64.f);
    float vs = 0.f;
#pragma unroll
    for (int e = 0; e < 8; ++e) { y[e] -= mu; vs += y[e] * y[e]; }
    vs = allred8(vs);
    const float rs = rsqrtf(vs * (1.f / 64.f) + 64e-5f);
    float ov[8];
#pragma unroll
    for (int q = 0; q < 4; ++q) {
      const float g0 = q < 2 ? ga[2 * q] : gb[2 * q - 4], g1 = q < 2 ? ga[2 * q + 1] : gb[2 * q - 3];
      const float b0 = q < 2 ? ba[2 * q] : bb[2 * q - 4], b1 = q < 2 ? ba[2 * q + 1] : bb[2 * q - 3];
      ov[2 * q] = (y[2 * q] * rs * g0 + b0 + LO(bow[q])) * LO(ggw[q]);
      ov[2 * q + 1] = (y[2 * q + 1] * rs * g1 + b1 + HI(bow[q])) * HI(ggw[q]);
    }
    *(uint4*)&CAT[(size_t)row * 1024 + l32 * 8] = make_uint4(pack2(ov[0], ov[1]), pack2(ov[2], ov[3]), pack2(ov[4], ov[5]), pack2(ov[6], ov[7]));
  }
}

#define XB_TMO      128
#define XB_XCNT(j)  (256  + 64 * (j))
#define XB_XSUB(j)  (1280 + 64 * (j))
#define XB_XGEN(j)  (2304 + 64 * (j))
#define XB_TOP      3328
#define XB_TOPGEN   3392
#define XB_SPIN_CAP (1u << 20)
DI unsigned xb_ld(unsigned* p) { return __hip_atomic_load(p, __ATOMIC_RELAXED, __HIP_MEMORY_SCOPE_AGENT); }
DI unsigned xb_add(unsigned* p, unsigned v) { return __hip_atomic_fetch_add(p, v, __ATOMIC_RELAXED, __HIP_MEMORY_SCOPE_AGENT); }
DI unsigned xb_xcc_id() { return (unsigned)__builtin_amdgcn_s_getreg((3 << 11) | 20) & 0xFu; }
#define XB_SPIN(cond, bar) do { unsigned _sp = 0; while (cond) { __builtin_amdgcn_s_sleep(1); \
    if ((++_sp & 255u) == 0u) { if (xb_ld(&(bar)[XB_TMO])) break; if (_sp > XB_SPIN_CAP) { atomicAdd(&(bar)[XB_TMO], 1u); break; } } } } while (0)
struct XcdBarrier { unsigned* bar; unsigned x; volatile LAS unsigned* st; };
DI XcdBarrier xcd_barrier_post(unsigned* bar, volatile LAS unsigned* st) {
  XcdBarrier b; b.bar = bar; b.x = xb_xcc_id(); b.st = st;
  if (threadIdx.x == 0) (void)xb_add(&bar[XB_XCNT(b.x)], 1u);
  return b;
}
DI void xcd_barrier_complete(unsigned* bar, unsigned x, unsigned& nloc, unsigned& nx) {
  const unsigned G = gridDim.x * gridDim.y * gridDim.z;
  unsigned sum, cnt, mine, sp = 0u;
  for (;;) {
    sum = 0u; cnt = 0u; mine = 0u;
#pragma unroll
    for (unsigned j = 0; j < 16; ++j) { const unsigned c = xb_ld(&bar[XB_XCNT(j)]); sum += c; cnt += (c > 0u) ? 1u : 0u; mine = (j == x) ? c : mine; }
    if (sum == G) break;
    __builtin_amdgcn_s_sleep(1);
    if ((++sp & 255u) == 0u) { if (xb_ld(&bar[XB_TMO])) break; if (sp > XB_SPIN_CAP) { atomicAdd(&bar[XB_TMO], 1u); break; } }
  }
  nloc = mine > 0u ? mine : 1u; nx = cnt > 0u ? cnt : 1u;
}
DI void xcd_barrier(const XcdBarrier& b) {
  asm volatile("s_waitcnt vmcnt(0)" ::: "memory");
  __syncthreads();
  if (threadIdx.x == 0) {
    unsigned* bar = b.bar;
    __builtin_amdgcn_s_waitcnt(0);
    unsigned nloc = b.st[0], nx = b.st[1];
    if (nloc == 0u) { xcd_barrier_complete(bar, b.x, nloc, nx); b.st[0] = nloc; b.st[1] = nx; }
    const unsigned old = xb_add(&bar[XB_XSUB(b.x)], 1u);
    const unsigned gen = old / nloc;
    if (old + 1u == (gen + 1u) * nloc) {
      __builtin_amdgcn_fence(__ATOMIC_RELEASE, "agent");
      asm volatile("s_waitcnt vmcnt(0)" ::: "memory");
      const unsigned og = xb_add(&bar[XB_TOP], 1u);
      const unsigned tg = og / nx;
      if (og + 1u == (tg + 1u) * nx) xb_add(&bar[XB_TOPGEN], 1u);
      else XB_SPIN(xb_ld(&bar[XB_TOPGEN]) == tg, bar);
      __builtin_amdgcn_fence(__ATOMIC_ACQUIRE, "agent");
      xb_add(&bar[XB_XGEN(b.x)], 1u);
      asm volatile("s_waitcnt vmcnt(0)" ::: "memory");
    } else {
      XB_SPIN(xb_ld(&bar[XB_XGEN(b.x)]) == gen, bar);
      __builtin_amdgcn_fence(__ATOMIC_ACQUIRE, "agent");
      asm volatile("s_waitcnt vmcnt(0)" ::: "memory");
    }
  }
  __syncthreads();
}

constexpr int NPHASE = 26;
#ifndef REPMASK
#define REPMASK 0
#endif
#ifndef SYNCX
#define SYNCX 0
#endif
__global__ void __launch_bounds__(NTHR) mega(P p) {
  cg::grid_group grid = cg::this_grid();
  if (p.ph_hi > 1000) grid.sync();
  volatile LAS unsigned* stw = (volatile LAS unsigned*)((LAS unsigned char*)smem + LDS_CTL + 16);
  if (threadIdx.x < 4) stw[threadIdx.x] = 0u;
  __syncthreads();
  const XcdBarrier xb = xcd_barrier_post((unsigned*)(p.ws + WS_BAR), stw);
#define GSYNC() xcd_barrier(xb)
  const u16* H = (const u16*)(p.ws + WS_H);
  const u16* ACT = (const u16*)(p.ws + WS_ACT);
  const u16* WIN = (const u16*)(p.ws + WS_WIN);
  const u16* WOUT = (const u16*)(p.ws + WS_WOUT);
  const u16* WMIN = (const u16*)(p.ws + WS_MIN);
  const u16* WMOUT = (const u16*)(p.ws + WS_MOUT);
  for (int ph = p.ph_lo; ph < p.ph_hi; ++ph) {
    if (ph == 0) {
      prep_phase(p, 0);
    } else if (ph == 25) {
      final_phase(p);
    } else {
      const int l = (ph - 1) / 12, s = (ph - 1) % 12;
      const int Mx = (l == 1) ? TX : T;
      float* xo = p.out;
      u16* ACTw = (u16*)(p.ws + WS_ACT);
      for (int rep = 0; rep < 1 + ((REPMASK >> s) & 1); ++rep) {
      switch (s) {
        case 0: if (rep == 0 && l == 1) prep_phase(p, 1); norm_phase(p, l, 0, 0, l == 0, T, (l == 1 && rep == 0) ? 8 : 0); break;
        case 1: gemm_phase(Gemm{H, WIN, T, 5632, 1024}, EpiSwiglu{ACTw}); break;
        case 2: gemm_phase(Gemm{ACT, WOUT, T, 1024, 2816}, EpiResid{xo, p.ws, l, 2, 1, 1}, TX, 8); break;
        case 3: norm_phase(p, l, 1, 3, false, T, rep == 0 ? 8 : 0); break;
        case 4: gemm_phase(Gemm{H, WMIN, T, PINP, 1024}, EpiMix{p.ws}); break;
        case 5: prepconv_phase(p, l, rep); break;
        case 6: mixer_phase(p, l, rep); break;
        case 7: finish_phase(p, l, Mx); break;
        case 8: gemm_phase(Gemm{H, WMOUT, Mx, 1024, 1024}, EpiResid{xo, p.ws, l, 5, 0, l == 0}, TX, l == 0 ? 4 : 0); break;
        case 9: norm_phase(p, l, 2, 6, false, Mx, (l == 0 && rep == 0) ? 4 : 0); break;
        case 10: gemm_phase(Gemm{H, WIN + (size_t)5632 * 1024, Mx, 5632, 1024}, EpiSwiglu{ACTw}); break;
        case 11: gemm_phase(Gemm{ACT, WOUT + (size_t)1024 * 2816, Mx, 1024, 2816}, EpiResid{xo, p.ws, l, 8, 1, l == 0}, TX, l == 0 ? 8 : 0); break;
      }
      if (rep + 1 < 1 + ((REPMASK >> s) & 1)) GSYNC();
      }
    }
    if (ph + 1 < p.ph_hi) { GSYNC(); for (int q = 0; q < SYNCX; ++q) GSYNC(); }
  }
}

extern "C" void kernel_launch(void* const* d_in, const int* in_sizes, int n_in, void* d_out, int out_size, void* d_ws,
                              size_t ws_size, hipStream_t stream) {
  static int grid = 0;
  if (grid == 0) {
    if (n_in != 29 || ws_size < WS_END) {
      fprintf(stderr, "kernel_launch: need 29 inputs and %zu bytes of ws; got %d, %zu\n", (size_t)WS_END, n_in, ws_size);
      grid = -1; return;
    }
    int dev = 0, cus = 0, per_cu = 0;
    hipGetDevice(&dev);
    hipDeviceGetAttribute(&cus, hipDeviceAttributeMultiprocessorCount, dev);
    if (hipFuncSetAttribute((const void*)mega, hipFuncAttributeMaxDynamicSharedMemorySize, LDS_BYTES) != hipSuccess) {
      fprintf(stderr, "kernel_launch: hipFuncSetAttribute failed\n"); grid = -1; return;
    }
    hipOccupancyMaxActiveBlocksPerMultiprocessor(&per_cu, (const void*)mega, NTHR, LDS_BYTES);
    if (per_cu < 1) { fprintf(stderr, "kernel_launch: occupancy query says %d blocks/CU\n", per_cu); per_cu = 1; }
    (void)hipGetLastError();
    grid = cus;
  }
  if (grid < 0) return;
  P p{};
  const float** pp = (const float**)&p;
  for (int i = 0; i < 29; ++i) pp[i] = (const float*)d_in[i];
  p.out = (float*)d_out;
  p.ws = (unsigned char*)d_ws;
  p.ph_lo = 0; p.ph_hi = NPHASE;
  if (hipMemsetAsync((char*)d_ws + WS_BAR, 0, BAR_BYTES, stream) != hipSuccess) { fprintf(stderr, "kernel_launch: memset failed\n"); return; }
  void* args[] = {&p};
  hipError_t e = hipLaunchCooperativeKernel((const void*)mega, dim3(grid), dim3(NTHR), args, LDS_BYTES, stream);
  if (e != hipSuccess) fprintf(stderr, "cooperative launch failed: %s (grid %d)\n", hipGetErrorString(e), grid);
}
```

```cpp
#include <hip/hip_runtime.h>
#include <hip/hip_bf16.h>
#include <hip/hip_cooperative_groups.h>
#include <cstdio>
namespace cg = cooperative_groups;

typedef unsigned short u16;
using bf16x8 = __attribute__((ext_vector_type(8))) short;
using s16x4 = __attribute__((ext_vector_type(4))) short;
using f32x4 = __attribute__((ext_vector_type(4))) float;
using f32x16 = __attribute__((ext_vector_type(16))) float;
#define DI __device__ __forceinline__

constexpr int D = 1024, TX = 16384, TCX = 2048, T = 18432, DFF = 2816, PINP = 3328;
constexpr int NTHR = 512;
#define MIXPROBE 0
constexpr int LDS_BYTES = 131072 + 256;
constexpr int LDS_CTL = 131072;

constexpr size_t WS_WIN = 0;
constexpr size_t WS_WOUT = WS_WIN + 2ull * 5632 * 1024 * 2;
constexpr size_t WS_MIN = WS_WOUT + 2ull * 1024 * 2816 * 2;
constexpr size_t WS_MOUT = WS_MIN + 3328ull * 1024 * 2;
constexpr size_t WS_XC = WS_MOUT + 1024ull * 1024 * 2;
constexpr size_t WS_MOD = WS_XC + 2048ull * 1024 * 4;
constexpr size_t WS_ROPE = WS_MOD + 2ull * 9 * 9216 * 4;
constexpr size_t WS_MISC = WS_ROPE + 64 * 16 * 2 * 4;
constexpr size_t WS_BAR = WS_MISC + 256;
constexpr size_t BAR_BYTES = 3456 * 4;
constexpr size_t WS_LORA = WS_BAR + 16384;
constexpr size_t WS_H = WS_LORA + 196608ull * 2;
constexpr size_t WS_R1 = WS_H + (size_t)T * 1024 * 2;
constexpr size_t SZ256 = (size_t)T * 256 * 2;
constexpr size_t WS_ACT = WS_R1;
constexpr size_t WS_FR = WS_R1;
constexpr size_t WS_Y = WS_R1;
constexpr size_t WS_SLAB = WS_R1 + 112ull * 1024 * 1024;
constexpr size_t WS_FC = WS_FR + (size_t)T * 1152 * 2;
constexpr size_t WS_Q = WS_FC + (size_t)T * 512 * 2;
constexpr size_t WS_KK = WS_Q + (size_t)T * 512 * 2;
constexpr size_t WS_VT = WS_KK + (size_t)T * 512 * 2;
constexpr size_t WS_SC = WS_VT + (size_t)T * 512 * 2;
constexpr size_t WS_G = WS_SC + 9 * SZ256;
constexpr size_t WS_BON = WS_G + SZ256;
constexpr size_t WS_END = WS_BON + SZ256;

struct P {
  const float *x, *c, *ctx, *c_ctx, *ada_w, *ada_b, *norm_g, *ffn_w_in, *ffn_w_out, *mix_w_in, *mix_w_out,
      *mu, *w0, *w2, *a0, *a2, *g2, *kk, *ka, *rk, *ln_g, *ln_b, *dw_w, *dw_b, *cln_g, *cln_b, *lam, *dng, *final_g;
  float* out;
  unsigned char* ws;
  int ph_lo, ph_hi;
};

extern __shared__ __attribute__((aligned(16))) unsigned char smem[];

DI int otid() { int t = threadIdx.x; asm volatile("" : "+v"(t)); return t; }
DI int obid() { int b = blockIdx.x; asm volatile("" : "+s"(b)); return b; }
DI u16 f2bf(float x) { __bf16 b = (__bf16)x; return __builtin_bit_cast(u16, b); }
DI float bf2f(u16 h) { return __uint_as_float(((unsigned)h) << 16); }
DI unsigned pack2(float a, float b) { return (unsigned)f2bf(a) | ((unsigned)f2bf(b) << 16); }
DI float sigm(float x) { return __builtin_amdgcn_rcpf(1.f + __builtin_amdgcn_exp2f(-1.4426950408889634f * x)); }
DI float wave_sum(float v);
template <int CTRL> DI float dppx(float v) {
  return __int_as_float(__builtin_amdgcn_update_dpp(0, __float_as_int(v), CTRL, 0xF, 0xF, true));
}
DI float allred16(float v) {
  v += dppx<0xB1>(v); v += dppx<0x4E>(v); v += dppx<0x141>(v); v += dppx<0x140>(v);
  return v;
}
DI float wave_sum(float v) {
  v = allred16(v);
  v += __shfl_xor(v, 16);
  v += __shfl_xor(v, 32);
  return v;
}
DI float* xrow(const P& p, int row) {
  return row < TX ? p.out + (size_t)row * D : (float*)(p.ws + WS_XC) + (size_t)(row - TX) * D;
}

DI void tr_tile(const float* W, int N, int K, u16* Wt, int kt, int ntile, int mode) {
  float* tile = (float*)smem;
  const int tid = otid();
  const int k0 = kt * 64, np0 = ntile * 64;
  int n0 = np0; bool valid = true;
  if (mode == 1) { int tl = np0 >> 8, half = (np0 >> 7) & 1, jj = np0 & 127; n0 = half * DFF + tl * 128 + jj; }
  if (mode == 2) { valid = np0 < 3200; }
  {
    const int kr = tid >> 4, nc = (tid & 15) * 4;
#pragma unroll
    for (int pz = 0; pz < 2; ++pz) {
      const int k = kr + 32 * pz;
      float4 v = make_float4(0.f, 0.f, 0.f, 0.f);
      if (valid) v = *(const float4*)&W[(size_t)(k0 + k) * N + n0 + nc];
      tile[k * 65 + nc + 0] = v.x; tile[k * 65 + nc + 1] = v.y; tile[k * 65 + nc + 2] = v.z; tile[k * 65 + nc + 3] = v.w;
    }
  }
  __syncthreads();
  {
    const int np = tid >> 3, ks = (tid & 7) * 8;
    uint4 o;
    o.x = pack2(tile[(ks + 0) * 65 + np], tile[(ks + 1) * 65 + np]);
    o.y = pack2(tile[(ks + 2) * 65 + np], tile[(ks + 3) * 65 + np]);
    o.z = pack2(tile[(ks + 4) * 65 + np], tile[(ks + 5) * 65 + np]);
    o.w = pack2(tile[(ks + 6) * 65 + np], tile[(ks + 7) * 65 + np]);
    *(uint4*)&Wt[(size_t)(np0 + np) * K + k0 + ks] = o;
  }
  __syncthreads();
}

DI void mod_item(const P& p, int idx) {
  float* cond = (float*)smem;
  float* red = cond + 9216;
  const int tid = otid(), lane = tid & 63, w = tid >> 6;
  const int l2 = idx / 144, n0 = (idx % 144) * 64;
  for (int i = tid; i < 9216; i += NTHR) {
    int m = i >> 10, k = i & 1023;
    float v = m < 8 ? p.c[m * 1024 + k] : p.c_ctx[k];
    cond[i] = v * sigm(v);
  }
  __syncthreads();
  float acc[9];
#pragma unroll
  for (int m = 0; m < 9; ++m) acc[m] = 0.f;
  const float* wp = p.ada_w + ((size_t)l2 * 1024 + w * 128) * 9216 + n0 + lane;
#pragma unroll 4
  for (int k = 0; k < 128; ++k) {
    float wv = wp[(size_t)k * 9216];
#pragma unroll
    for (int m = 0; m < 9; ++m) acc[m] += cond[m * 1024 + w * 128 + k] * wv;
  }
#pragma unroll
  for (int m = 0; m < 9; ++m) red[(w * 9 + m) * 64 + lane] = acc[m];
  __syncthreads();
  float* mod = (float*)(p.ws + WS_MOD);
  for (int o = tid; o < 576; o += NTHR) {
    int m = o >> 6, ln = o & 63;
    float s = 0.f;
#pragma unroll
    for (int ww = 0; ww < 8; ++ww) s += red[(ww * 9 + m) * 64 + ln];
    mod[(size_t)(l2 * 9 + m) * 9216 + n0 + ln] = s + p.ada_b[l2 * 9216 + n0 + ln];
  }
  __syncthreads();
}

DI void misc_item(const P& p) {
  const int tid = otid();
  float* rope = (float*)(p.ws + WS_ROPE);
  for (int i = tid; i < 1024; i += NTHR) {
    int pos = i >> 4, f = i & 15;
    float inv = exp2f(-(float)f * (13.287712379549449f / 16.f));
    float ang = (float)pos * inv;
    float kq = rintf(ang * 0.15915494309189535f);
    float r = fmaf(-kq, 6.28125f, ang);
    r = fmaf(-kq, 1.9353071795864769e-3f, r);
    rope[i * 2 + 0] = cosf(r);
    rope[i * 2 + 1] = sinf(r);
  }
  if (tid < 2) {
    const float* lv = p.lam + tid * 256;
    float s1 = 0.f, s2 = 0.f;
    for (int i = 0; i < 64; ++i) { s1 += lv[i] * lv[64 + i]; s2 += lv[128 + i] * lv[192 + i]; }
    float li = 0.8f - 0.6f * expf(-0.3f * (float)tid);
    float* mf = (float*)(p.ws + WS_MISC);
    mf[tid] = expf(s1) - expf(s2) + li;
    mf[2 + tid] = li;
  }
  if (tid >= 8 && tid < 16) ((unsigned*)(p.ws + WS_MISC))[tid] = 0u;
}

DI void lora_item(const P& p, int i) {
  u16* LW = (u16*)(p.ws + WS_LORA);
  const int tid = otid();
#pragma unroll
  for (int q = 0; q < 4; ++q) {
    const int e = i * 2048 + q * NTHR + tid;
    float v;
    if (e < 131072) {
      const int e1 = e & 65535, r = e1 & 63, c = (e1 >> 6) & 255, ld = e1 >> 14;
      const float* src = e < 65536 ? p.w2 : p.a2;
      v = src[((size_t)ld * 64 + r) * 256 + c];
    } else {
      const int e1 = e - 131072, r = e1 & 127, c = (e1 >> 7) & 255, l_ = e1 >> 15;
      v = p.g2[((size_t)l_ * 128 + r) * 256 + c];
    }
    LW[e] = f2bf(v);
  }
}

DI void prep_phase(const P& p, int l) {
  const int nconv = 2816 + 1408 + 832 + 256;
  const int total = nconv + (l == 0 ? 289 + 96 : 0);
  for (int it = obid(); it < total; it += gridDim.x) {
    if (it < 2816) {
      int s = it / 1408, r = it % 1408;
      tr_tile(p.ffn_w_in + (size_t)(l * 2 + s) * 1024 * 5632, 5632, 1024, (u16*)(p.ws + WS_WIN) + (size_t)s * 5632 * 1024, r / 88, r % 88, 1);
    } else if (it < 2816 + 1408) {
      int q = it - 2816; int s = q / 704, r = q % 704;
      tr_tile(p.ffn_w_out + (size_t)(l * 2 + s) * 2816 * 1024, 1024, 2816, (u16*)(p.ws + WS_WOUT) + (size_t)s * 1024 * 2816, r / 16, r % 16, 0);
    } else if (it < 2816 + 1408 + 832) {
      int r = it - 4224;
      tr_tile(p.mix_w_in + (size_t)l * 1024 * 3200, 3200, 1024, (u16*)(p.ws + WS_MIN), r / 52, r % 52, 2);
    } else if (it < nconv) {
      int r = it - 5056;
      tr_tile(p.mix_w_out + (size_t)l * 1024 * 1024, 1024, 1024, (u16*)(p.ws + WS_MOUT), r / 16, r % 16, 0);
    } else if (it < nconv + 288) {
      mod_item(p, it - nconv);
    } else if (it == nconv + 288) {
      misc_item(p);
    } else {
      lora_item(p, it - nconv - 289);
    }
  }
}

DI void norm_phase(const P& p, int l, int gi, int si, bool first, int rows, int nslab = 0, bool ctxin = false) {
  const int lane = otid() & 63, w = otid() >> 6;
  const float* modb = (const float*)(p.ws + WS_MOD);
  u16* H = (u16*)(p.ws + WS_H);
  const float* g = p.norm_g + (size_t)(l * 3 + gi) * 1024;
  const int nw = (int)gridDim.x * 8, wid = obid() * 8 + w;
  const int per = nw >> 3;
  const bool grouped = (nw & 7) == 0 && per > 0 && (2048 % per) == 0;
  const int grp = grouped ? wid / per : 0, sub = grouped ? wid - grp * per : 0;
  const int nx = grouped ? 2048 / per : 0;
  const int nsteps = grouped ? nx + ((rows > TX) ? (TCX + nw - 1) / nw : 0) : (rows + nw - 1) / nw;
  int cur_m = -1;
  f32x4 A[4], B[4];
  for (int st = 0; st < nsteps; ++st) {
    int row;
    if (!grouped) { row = st * nw + wid; if (row >= rows) break; }
    else if (st < nx) row = grp * 2048 + st * per + sub;
    else { row = TX + (st - nx) * nw + wid; if (row >= rows) break; }
    const int mrow = row < TX ? (row >> 11) : 8;
    if (mrow != cur_m) {
      const float* md = modb + (size_t)(l * 9 + mrow) * 9216;
#pragma unroll
      for (int c = 0; c < 4; ++c) {
        const int k = (c >> 1) * 512 + lane * 8 + (c & 1) * 4;
        const f32x4 g4 = *(const f32x4*)&g[k], sh = *(const f32x4*)&md[si * 1024 + k], sc = *(const f32x4*)&md[(si + 1) * 1024 + k];
        A[c] = g4 * (sc + 1.f); B[c] = sh;
      }
      cur_m = mrow;
    }
    const bool fin = first || (ctxin && row >= TX);
    const float* src = fin ? (row < TX ? p.x + (size_t)row * D : p.ctx + (size_t)(row - TX) * D) : xrow(p, row);
    f32x4 v[4];
    const bool addsl = nslab > 0 && row >= TX;
#pragma unroll
    for (int c = 0; c < 4; ++c) v[c] = *(const f32x4*)&src[(c >> 1) * 512 + lane * 8 + (c & 1) * 4];
    if (addsl) {
      const float* sl = (const float*)(p.ws + WS_SLAB) + (size_t)(row - TX) * D;
      for (int q = 0; q < nslab; ++q) {
#pragma unroll
        for (int c = 0; c < 4; ++c) v[c] += *(const f32x4*)&sl[(size_t)q * TCX * D + (c >> 1) * 512 + lane * 8 + (c & 1) * 4];
      }
    }
    float ss = 0.f;
#pragma unroll
    for (int c = 0; c < 4; ++c) ss += v[c][0] * v[c][0] + v[c][1] * v[c][1] + v[c][2] * v[c][2] + v[c][3] * v[c][3];
    ss = wave_sum(ss);
    const float rstd = rsqrtf(ss * (1.f / 1024.f) + 1e-6f);
    float* xd = xrow(p, row);
#pragma unroll
    for (int c2 = 0; c2 < 2; ++c2) {
      const f32x4 ha = v[2 * c2] * rstd * A[2 * c2] + B[2 * c2], hb = v[2 * c2 + 1] * rstd * A[2 * c2 + 1] + B[2 * c2 + 1];
      *(uint4*)&H[(size_t)row * 1024 + c2 * 512 + lane * 8] = make_uint4(pack2(ha[0], ha[1]), pack2(ha[2], ha[3]), pack2(hb[0], hb[1]), pack2(hb[2], hb[3]));
      if (addsl) { *(f32x4*)&xd[c2 * 512 + lane * 8] = v[2 * c2]; *(f32x4*)&xd[c2 * 512 + lane * 8 + 4] = v[2 * c2 + 1]; }
    }
  }
}

DI void final_phase(const P& p) {
  const int lane = otid() & 63, w = otid() >> 6;
  float4 gq[4];
#pragma unroll
  for (int c = 0; c < 4; ++c) gq[c] = ((const float4*)p.final_g)[c * 64 + lane];
  for (int row = obid() * 8 + w; row < TX; row += gridDim.x * 8) {
    float* src = p.out + (size_t)row * D;
    float4 v[4];
    float ss = 0.f;
#pragma unroll
    for (int c = 0; c < 4; ++c) {
      v[c] = ((const float4*)src)[c * 64 + lane];
      ss += v[c].x * v[c].x + v[c].y * v[c].y + v[c].z * v[c].z + v[c].w * v[c].w;
    }
    ss = wave_sum(ss);
    const float rstd = rsqrtf(ss * (1.f / 1024.f) + 1e-6f);
#pragma unroll
    for (int c = 0; c < 4; ++c) {
      const float4 g4 = gq[c];
      float4 o = make_float4(v[c].x * rstd * g4.x, v[c].y * rstd * g4.y, v[c].z * rstd * g4.z, v[c].w * rstd * g4.w);
      ((float4*)src)[c * 64 + lane] = o;
    }
  }
}

#define LAS __attribute__((address_space(3)))
constexpr int BM = 256, BK = 64, HALF = 128, HTB = HALF * BK * 2;
DI int lds_byte(int r, int c) { const int st = (r >> 4) * 2 + (c >> 5), rr = r & 15, cc = c & 31, ob = rr * 64 + cc * 2; return st * 1024 + (ob ^ (((ob >> 9) & 1) << 5)); }
DI void stage_rc(int b, int& R, int& C) { const int st = b / 1024, sb = b % 1024, swz = sb ^ (((sb >> 9) & 1) << 5); R = (st >> 1) * 16 + swz / 64; C = (st & 1) * 32 + (swz % 64) / 2; }
DI int perm32(int rho) { const int n = rho >> 4, i = rho & 15; return 8 * (i >> 2) + 4 * n + (i & 3); }
struct Unit { int pm, pn, k0, nkt, q; };
struct Gemm { const u16* A; const u16* Bt; int M, N, K; };
struct StaticOrder {
  int nM, nN, nwg, G, c, nkt, S, ntail;
  DI void init(int M, int N, int K, int G_, int c_, int Mx, int S_) {
    nN = N / BM; G = G_; c = c_; nkt = K / BK; S = S_;
    nM = (S_ > 0 ? Mx : M) / BM; nwg = nM * nN;
    ntail = S_ > 0 ? ((M - Mx) / BM) * nN * S_ : 0;
  }
  DI bool next(int i, Unit& u) const {
    const long L = (long)i * G + c;
    if (L >= nwg + ntail) return false;
    if (L >= nwg) {
      const int r = (int)L - nwg, tt = r / S, q = r - tt * S, nkp = nkt >> 1;
      const int kp0 = (q * nkp) / S, kp1 = ((q + 1) * nkp) / S;
      u.pm = nM + tt / nN; u.pn = tt % nN; u.k0 = 2 * kp0; u.nkt = 2 * (kp1 - kp0); u.q = q;
      return true;
    }
    int wgid = (int)L; { const int q = nwg / 8, r = nwg % 8, xcd = wgid % 8, off = wgid / 8; wgid = (xcd < r ? xcd * (q + 1) : r * (q + 1) + (xcd - r) * q) + off; }
    const int nig = 8 * nN, gid = wgid / nig, fm = gid * 8, gsz = (nM - fm) < 8 ? (nM - fm) : 8;
    u.pm = fm + ((wgid % nig) % gsz); u.pn = (wgid % nig) / gsz; u.k0 = 0; u.nkt = nkt; u.q = 0; return true;
  }
};

struct EpiSwiglu {
  static constexpr bool PERM = true;
  u16* ACT;
  DI void operator()(const f32x4 (&acc)[2][2][4][2], const Unit& u, int wr, int wc, int fr, int fq) const {
    const int row0 = u.pm * BM + wr * 64 + fr, col0 = u.pn * 128 + wc * 32 + 8 * fq;
#pragma unroll
    for (int ai = 0; ai < 2; ++ai)
#pragma unroll
      for (int m = 0; m < 4; ++m) {
        const int row = row0 + ai * HALF + m * 16;
        float v[8];
#pragma unroll
        for (int n = 0; n < 2; ++n)
#pragma unroll
          for (int e = 0; e < 4; ++e) { const float gt = acc[ai][0][m][n][e], up = acc[ai][1][m][n][e]; v[n * 4 + e] = gt * sigm(gt) * up; }
        uint4 o; o.x = pack2(v[0], v[1]); o.y = pack2(v[2], v[3]); o.z = pack2(v[4], v[5]); o.w = pack2(v[6], v[7]);
        *(uint4*)&ACT[(size_t)row * DFF + col0] = o;
      }
  }
};
struct EpiResid {
  static constexpr bool PERM = false;
  float* out; unsigned char* ws; int l, gidx, half, tail; const float* xin;
  DI void operator()(const f32x4 (&acc)[2][2][4][2], const Unit& u, int wr, int wc, int fr, int fq) const {
    float* xc = (float*)(ws + WS_XC); const float* mod = (const float*)(ws + WS_MOD); float* slab = (float*)(ws + WS_SLAB);
    const float sc = half ? 0.5f : 1.f;
    const int brow = u.pm * BM;
    const int mrow = brow < TX ? (brow >> 11) : 8;
    const int col0 = u.pn * BM + wc * 32 + 4 * fq;
    const float* gate = mod + (size_t)(l * 9 + mrow) * 9216 + gidx * 1024 + col0;
    f32x4 gv[2][2];
#pragma unroll
    for (int bj = 0; bj < 2; ++bj)
#pragma unroll
      for (int n = 0; n < 2; ++n) gv[bj][n] = *(const f32x4*)(gate + bj * HALF + n * 16) * sc;
    if (tail && brow >= TX) {
      float* sp0 = slab + ((size_t)u.q * TCX + (size_t)(brow - TX + wr * 64 + fr)) * D + col0;
#pragma unroll
      for (int ai = 0; ai < 2; ++ai)
#pragma unroll
        for (int m = 0; m < 4; ++m)
#pragma unroll
          for (int bj = 0; bj < 2; ++bj)
#pragma unroll
            for (int n = 0; n < 2; ++n) *(f32x4*)(sp0 + (size_t)(ai * HALF + m * 16) * D + bj * HALF + n * 16) = gv[bj][n] * acc[ai][bj][m][n];
      return;
    }
#pragma unroll
    for (int ai = 0; ai < 2; ++ai) {
      f32x4 xv[4][2][2];
      float* xp0 = (brow < TX ? out + (size_t)(brow + ai * HALF + wr * 64 + fr) * D : xc + (size_t)(brow - TX + ai * HALF + wr * 64 + fr) * D) + col0;
      const float* rp0 = (brow < TX ? xin + (size_t)(brow + ai * HALF + wr * 64 + fr) * D : xc + (size_t)(brow - TX + ai * HALF + wr * 64 + fr) * D) + col0;
#pragma unroll
      for (int m = 0; m < 4; ++m)
#pragma unroll
        for (int bj = 0; bj < 2; ++bj)
#pragma unroll
          for (int n = 0; n < 2; ++n) xv[m][bj][n] = *(const f32x4*)(rp0 + (size_t)m * 16 * D + bj * HALF + n * 16);
#pragma unroll
      for (int m = 0; m < 4; ++m)
#pragma unroll
        for (int bj = 0; bj < 2; ++bj)
#pragma unroll
          for (int n = 0; n < 2; ++n) *(f32x4*)(xp0 + (size_t)m * 16 * D + bj * HALF + n * 16) = xv[m][bj][n] + gv[bj][n] * acc[ai][bj][m][n];
    }
  }
};
struct EpiMix {
  static constexpr bool PERM = false;
  unsigned char* ws;
  DI void operator()(const f32x4 (&acc)[2][2][4][2], const Unit& u, int wr, int wc, int fr, int fq) const {
    const float* rope = (const float*)(ws + WS_ROPE);
    const int brow = u.pm * BM, bcol = u.pn * BM;
    const bool isx = brow < TX;
    const int bb = isx ? (brow >> 11) : ((brow - TX) >> 8);
#pragma unroll
    for (int bj = 0; bj < 2; ++bj) {
      const int base32 = bcol + bj * HALF + wc * 32;
      if (base32 >= 3200) continue;
      if (base32 < 1664) {
        u16* dst; int ld, cb;
        if (base32 < 1152) { dst = (u16*)(ws + WS_FR); ld = 1152; cb = base32; }
        else { dst = (u16*)(ws + WS_FC); ld = 512; cb = base32 - 1152; }
#pragma unroll
        for (int ai = 0; ai < 2; ++ai)
#pragma unroll
          for (int m = 0; m < 4; ++m) {
            const int row = brow + ai * HALF + wr * 64 + m * 16 + fr;
            const uint2 q0 = make_uint2(pack2(acc[ai][bj][m][0][0], acc[ai][bj][m][0][1]), pack2(acc[ai][bj][m][0][2], acc[ai][bj][m][0][3]));
            const uint2 q1 = make_uint2(pack2(acc[ai][bj][m][1][0], acc[ai][bj][m][1][1]), pack2(acc[ai][bj][m][1][2], acc[ai][bj][m][1][3]));
            const bool od = fq & 1;
            const uint2 snd = od ? q0 : q1;
            const uint2 rcv = make_uint2((unsigned)__shfl_xor((int)snd.x, 16), (unsigned)__shfl_xor((int)snd.y, 16));
            const uint4 o4 = od ? make_uint4(rcv.x, rcv.y, q1.x, q1.y) : make_uint4(q0.x, q0.y, rcv.x, rcv.y);
            *(uint4*)&dst[(size_t)row * ld + cb + (od ? 16 + 4 * (fq - 1) : 4 * fq)] = o4;
          }
      } else if (base32 < 2688) {
        const bool isq = base32 < 2176;
        const int cb = isq ? base32 - 1664 : base32 - 2176;
        const int axis = (base32 >> 5) & 1;
        const float qs = isq ? 0.125f * 1.4426950408889634f : 1.f;
#pragma unroll
        for (int ai = 0; ai < 2; ++ai)
#pragma unroll
          for (int m = 0; m < 4; ++m) {
            const int row = brow + ai * HALF + wr * 64 + m * 16 + fr;
            f32x4 t1 = acc[ai][bj][m][0], t2 = acc[ai][bj][m][1];
            int keyidx;
            if (isx) {
              const int npos = row & 2047;
              const int ps = axis ? (npos & 63) : (npos >> 6);
              const f32x4 ca = *(const f32x4*)&rope[(ps * 16 + 4 * fq) * 2];
              const f32x4 cb4 = *(const f32x4*)&rope[(ps * 16 + 4 * fq) * 2 + 4];
              const f32x4 cs = {ca[0], ca[2], cb4[0], cb4[2]}, sn = {ca[1], ca[3], cb4[1], cb4[3]};
              const f32x4 o1 = t1 * cs - t2 * sn, o2 = t2 * cs + t1 * sn;
              t1 = o1; t2 = o2; keyidx = npos;
            } else keyidx = 2048 + ((row - TX) & 255);
            t1 = t1 * qs; t2 = t2 * qs;
            const uint2 q0 = make_uint2(pack2(t1[0], t1[1]), pack2(t1[2], t1[3]));
            const uint2 q1 = make_uint2(pack2(t2[0], t2[1]), pack2(t2[2], t2[3]));
            const bool od = fq & 1;
            const uint2 snd = od ? q0 : q1;
            const uint2 rcv = make_uint2((unsigned)__shfl_xor((int)snd.x, 16), (unsigned)__shfl_xor((int)snd.y, 16));
            const uint4 o4 = od ? make_uint4(rcv.x, rcv.y, q1.x, q1.y) : make_uint4(q0.x, q0.y, rcv.x, rcv.y);
            u16* dst = isq ? (u16*)(ws + WS_Q) + (size_t)row * 512 + cb
                           : (u16*)(ws + WS_KK) + ((size_t)bb * 2304 + keyidx) * 512 + cb;
            *(uint4*)(dst + (od ? 16 + 4 * (fq - 1) : 4 * fq)) = o4;
          }
      } else {
        u16* VT = (u16*)(ws + WS_VT);
        const int cb = base32 - 2688;
#pragma unroll
        for (int ai = 0; ai < 2; ++ai)
#pragma unroll
          for (int m = 0; m < 4; ++m) {
            const int rowb = brow + ai * HALF + wr * 64 + m * 16 + (fr & ~3);
            const int keyb = isx ? (rowb & 2047) : 2048 + ((rowb - TX) & 255);
            const bool od1 = fr & 1, od2 = (fr >> 1) & 1;
            unsigned own[8];
#pragma unroll
            for (int n = 0; n < 2; ++n)
#pragma unroll
              for (int e = 0; e < 4; ++e) own[n * 4 + e] = (unsigned)f2bf(acc[ai][bj][m][n][e]);
            unsigned pr[4];
#pragma unroll
            for (int i = 0; i < 4; ++i) {
              const unsigned snd = od1 ? own[i] : own[4 + i], kp = od1 ? own[4 + i] : own[i];
              const unsigned rc = (unsigned)__builtin_amdgcn_update_dpp(0, (int)snd, 0xB1, 0xF, 0xF, true);
              pr[i] = od1 ? (rc | (kp << 16)) : (kp | (rc << 16));
            }
#pragma unroll
            for (int j = 0; j < 2; ++j) {
              const unsigned snd = od2 ? pr[j] : pr[2 + j], kp = od2 ? pr[2 + j] : pr[j];
              const unsigned rc = (unsigned)__builtin_amdgcn_update_dpp(0, (int)snd, 0x4E, 0xF, 0xF, true);
              const uint2 o2 = od2 ? make_uint2(rc, kp) : make_uint2(kp, rc);
              const int cc = cb + (od1 ? 16 : 0) + 4 * fq + (od2 ? 2 : 0) + j;
              *(uint2*)&VT[((size_t)bb * 512 + cc) * 2304 + keyb] = o2;
            }
          }
      }
    }
  }
};

template <class Epi>
DI void gemm_phase(const Gemm g, const Epi& E, int Mx = 0, int S_ = 0) {
  LAS unsigned char* lds = (LAS unsigned char*)smem;
  StaticOrder S; S.init(g.M, g.N, g.K, (int)gridDim.x, (int)obid(), Mx, S_);
  const int tid = otid(), wid = __builtin_amdgcn_readfirstlane(tid >> 6), lane = tid & 63, wr = wid >> 2, wc = wid & 3, fr = lane & 15, fq = lane >> 4;
  const int K = g.K;
  unsigned voffA[2], voffB[2];
#pragma unroll
  for (int i = 0; i < 2; ++i) { int R, C; stage_rc(tid * 16 + i * 8192, R, C); const int Rb = Epi::PERM ? ((R & ~31) + perm32(R & 31)) : R;
    voffA[i] = (unsigned)(R * K + C) * 2u; voffB[i] = (unsigned)(Rb * K + C) * 2u; }
  const size_t kstep = (size_t)(BK * 2);
  const size_t hstep = (size_t)HALF * K * 2;
  const size_t tstep = 2 * hstep;
  const unsigned ldsw = (unsigned)wid * 1024u;
  const int aoff = lds_byte(wr * 64 + fr, fq * 8), boff = lds_byte(wc * 32 + fr, fq * 8);
#define PG8_SA(b, h) (((b) * 2 + (h)) * HTB)
#define PG8_SB(b, h) ((4 + (b) * 2 + (h)) * HTB)
#define PG8_STAGE(bufoff, gbase, voff) do { _Pragma("unroll") for (int _i = 0; _i < 2; ++_i) \
    __builtin_amdgcn_global_load_lds((const unsigned*)((const char*)(gbase) + (voff)[_i]), (LAS unsigned*)(lds + (bufoff) + ldsw + _i * 8192), 16, 0, 0); } while (0)
#define PG8_LDA(dst, b, h) do { _Pragma("unroll") for (int m = 0; m < 4; ++m) _Pragma("unroll") for (int k = 0; k < 2; ++k) dst[m][k] = *(const LAS bf16x8*)(lds + PG8_SA(b, h) + aoff + m * 2048 + k * 1024); } while (0)
#define PG8_LDB(dst, b, h) do { _Pragma("unroll") for (int n = 0; n < 2; ++n) _Pragma("unroll") for (int k = 0; k < 2; ++k) dst[n][k] = *(const LAS bf16x8*)(lds + PG8_SB(b, h) + boff + n * 2048 + k * 1024); } while (0)
#define PG8_MMA(ai, bj, At, Bt) do { __builtin_amdgcn_s_setprio(1); _Pragma("unroll") for (int m = 0; m < 4; ++m) _Pragma("unroll") for (int n = 0; n < 2; ++n) _Pragma("unroll") for (int k = 0; k < 2; ++k) \
    acc[ai][bj][m][n] = __builtin_amdgcn_mfma_f32_16x16x32_bf16(Bt[n][k], At[m][k], acc[ai][bj][m][n], 0, 0, 0); __builtin_amdgcn_s_setprio(0); } while (0)
#define PG8_WAIT_V(n) asm volatile("s_waitcnt vmcnt(" #n ")" ::: "memory")
#define PG8_WAIT_L(n) asm volatile("s_waitcnt lgkmcnt(" #n ")" ::: "memory")
#define PG8_BAR __builtin_amdgcn_s_barrier()
#define PG8_SCHED __builtin_amdgcn_sched_barrier(0)
  Unit cur, nxt; int ui = 0;
  if (!S.next(0, cur)) return;
  f32x4 acc[2][2][4][2];
#pragma unroll
  for (int a = 0; a < 2; ++a)
#pragma unroll
    for (int b = 0; b < 2; ++b)
#pragma unroll
      for (int m = 0; m < 4; ++m)
#pragma unroll
        for (int n = 0; n < 2; ++n) acc[a][b][m][n] = (f32x4){0.f, 0.f, 0.f, 0.f};
  bf16x8 At[4][2], B0[2][2], B1[2][2];
  const char* cA = (const char*)g.A + (size_t)cur.pm * tstep + (size_t)cur.k0 * kstep; const char* cB = (const char*)g.Bt + (size_t)cur.pn * tstep + (size_t)cur.k0 * kstep;
  PG8_STAGE(PG8_SB(0, 0), cB, voffB); PG8_STAGE(PG8_SA(0, 0), cA, voffA); PG8_STAGE(PG8_SB(0, 1), cB + hstep, voffB); PG8_STAGE(PG8_SA(0, 1), cA + hstep, voffA);
  if (wr == 1) PG8_BAR;
  PG8_WAIT_V(4); PG8_BAR;
  PG8_STAGE(PG8_SB(1, 0), cB + kstep, voffB); PG8_STAGE(PG8_SA(1, 0), cA + kstep, voffA); PG8_STAGE(PG8_SB(1, 1), cB + hstep + kstep, voffB);
  PG8_WAIT_V(6); PG8_BAR;
  for (;;) {
    const bool has_next = S.next(ui + 1, nxt);
    const char* nA = has_next ? (const char*)g.A + (size_t)nxt.pm * tstep + (size_t)nxt.k0 * kstep : cA; const char* nB = has_next ? (const char*)g.Bt + (size_t)nxt.pn * tstep + (size_t)nxt.k0 * kstep : cB;
    const int nt = cur.nkt;
    for (int t = 0; t < nt; t += 2) {
      const bool last = (t == nt - 2);
      const char* a1 = cA + (size_t)(t + 1) * kstep;
      const char* a2 = last ? nA : cA + (size_t)(t + 2) * kstep; const char* b2 = last ? nB : cB + (size_t)(t + 2) * kstep;
      const char* a3 = a2 + kstep; const char* b3 = b2 + kstep;
      PG8_LDB(B0, 0, 0); PG8_SCHED; PG8_LDA(At, 0, 0); PG8_STAGE(PG8_SA(1, 1), a1 + hstep, voffA);
      PG8_WAIT_L(8); PG8_BAR; PG8_WAIT_L(0); PG8_MMA(0, 0, At, B0); PG8_BAR; PG8_SCHED;
      PG8_LDB(B1, 0, 1); PG8_STAGE(PG8_SB(0, 0), b2, voffB);
      PG8_BAR; PG8_WAIT_L(0); PG8_MMA(0, 1, At, B1); PG8_BAR;
      PG8_LDA(At, 0, 1); PG8_STAGE(PG8_SA(0, 0), a2, voffA);
      PG8_BAR; PG8_WAIT_L(0); PG8_MMA(1, 0, At, B0); PG8_BAR; PG8_SCHED;
      PG8_STAGE(PG8_SB(0, 1), b2 + hstep, voffB);
      PG8_WAIT_V(6); PG8_BAR; PG8_MMA(1, 1, At, B1); PG8_BAR;
      PG8_LDB(B0, 1, 0); PG8_SCHED; PG8_LDA(At, 1, 0); PG8_STAGE(PG8_SA(0, 1), a2 + hstep, voffA);
      PG8_WAIT_L(8); PG8_BAR; PG8_WAIT_L(0); PG8_MMA(0, 0, At, B0); PG8_BAR; PG8_SCHED;
      PG8_LDB(B1, 1, 1); PG8_STAGE(PG8_SB(1, 0), b3, voffB);
      PG8_BAR; PG8_WAIT_L(0); PG8_MMA(0, 1, At, B1); PG8_BAR;
      PG8_LDA(At, 1, 1); PG8_STAGE(PG8_SA(1, 0), a3, voffA);
      PG8_BAR; PG8_WAIT_L(0); PG8_MMA(1, 0, At, B0); PG8_BAR; PG8_SCHED;
      PG8_STAGE(PG8_SB(1, 1), b3 + hstep, voffB);
      PG8_WAIT_V(6); PG8_BAR; PG8_MMA(1, 1, At, B1); PG8_BAR;
    }
    E(acc, cur, wr, wc, fr, fq);
    if (!has_next) break;
#pragma unroll
    for (int a = 0; a < 2; ++a)
#pragma unroll
      for (int b = 0; b < 2; ++b)
#pragma unroll
        for (int m = 0; m < 4; ++m)
#pragma unroll
          for (int n = 0; n < 2; ++n) acc[a][b][m][n] = (f32x4){0.f, 0.f, 0.f, 0.f};
    cur = nxt; cA = nA; cB = nB; ++ui;
  }
  PG8_WAIT_V(0);
  if (wr == 0) PG8_BAR;
  PG8_BAR;
#undef PG8_SA
#undef PG8_SB
#undef PG8_STAGE
#undef PG8_LDA
#undef PG8_LDB
#undef PG8_MMA
}


constexpr int FS_LD = 772;
constexpr int AB_LD = 392;
constexpr int PRM_OFF = 32 * FS_LD * 4 + 32 * AB_LD * 2;
DI float blo(unsigned u) { return __uint_as_float(u << 16); }
DI float bhi(unsigned u) { return __uint_as_float(u & 0xffff0000u); }
DI void rwkv_prep_item(const P& p, int l, int item) {
  float* fs = (float*)smem;
  u16* ab = (u16*)(smem + 32 * FS_LD * 4);
  const int tid = otid();
  const int t0 = item * 32;
  int L, n0;
  if (t0 < TX) { L = 2048; n0 = t0 & 2047; } else { L = 256; n0 = (t0 - TX) & 255; }
  const u16* FR = (const u16*)(p.ws + WS_FR);
  const float* mu0 = p.mu + (size_t)l * 2 * 1152;
  const float* mu1 = mu0 + 1152;
  {
    uint4 fu[9], pu[9], nu[9];
#pragma unroll
    for (int q = 0; q < 9; ++q) {
      const int idx = q * NTHR + tid;
      const int tk = idx / 144, ci = (idx - tk * 144) * 8;
      const int n = n0 + tk;
      const size_t row = (size_t)(t0 + tk);
      fu[q] = *(const uint4*)&FR[row * 1152 + ci];
      pu[q] = *(const uint4*)&FR[(row - (n > 0 ? 1 : 0)) * 1152 + ci];
      nu[q] = *(const uint4*)&FR[(row + (n < L - 1 ? 1 : 0)) * 1152 + ci];
    }
#pragma unroll
    for (int q = 0; q < 9; ++q) {
      const int idx = q * NTHR + tid;
      const int tk = idx / 144, ci = (idx - tk * 144) * 8;
      const int n = n0 + tk;
      const uint4 z4 = make_uint4(0u, 0u, 0u, 0u);
      const uint4 pq = n > 0 ? pu[q] : z4, nq = n < L - 1 ? nu[q] : z4;
      const unsigned fw[4] = {fu[q].x, fu[q].y, fu[q].z, fu[q].w}, pw_[4] = {pq.x, pq.y, pq.z, pq.w}, nw_[4] = {nq.x, nq.y, nq.z, nq.w};
      f32x4 v[2];
#pragma unroll
      for (int hlf = 0; hlf < 2; ++hlf) {
        const f32x4 m0 = *(const f32x4*)&mu0[ci + 4 * hlf], m1 = *(const f32x4*)&mu1[ci + 4 * hlf];
        const f32x4 ff = {blo(fw[2 * hlf]), bhi(fw[2 * hlf]), blo(fw[2 * hlf + 1]), bhi(fw[2 * hlf + 1])};
        const f32x4 pp = {blo(pw_[2 * hlf]), bhi(pw_[2 * hlf]), blo(pw_[2 * hlf + 1]), bhi(pw_[2 * hlf + 1])};
        const f32x4 nn = {blo(nw_[2 * hlf]), bhi(nw_[2 * hlf]), blo(nw_[2 * hlf + 1]), bhi(nw_[2 * hlf + 1])};
        v[hlf] = ff + m0 * (pp - ff) + m1 * (nn - ff);
      }
      if (ci < 768) { *(f32x4*)&fs[tk * FS_LD + ci] = v[0]; *(f32x4*)&fs[tk * FS_LD + ci + 4] = v[1]; }
      else {
        const bool isT = ci < 896, isS = ci >= 1024;
        const float sc = isT ? 2.f : 1.f;
#pragma unroll
        for (int hlf = 0; hlf < 2; ++hlf)
#pragma unroll
          for (int e = 0; e < 4; ++e) { const float y = sigm(sc * v[hlf][e]); v[hlf][e] = isT ? 2.f * y - 1.f : (isS ? y : v[hlf][e]); }
        *(uint4*)&ab[tk * AB_LD + (ci - 768)] = make_uint4(pack2(v[0][0], v[0][1]), pack2(v[0][2], v[0][3]), pack2(v[1][0], v[1][1]), pack2(v[1][2], v[1][3]));
      }
    }
  }
  __syncthreads();
  const int lane = tid & 63, w = tid >> 6, h = w & 3, mt = w >> 2, col = lane & 15, kc = lane >> 4;
  bf16x8 af_[12];
#pragma unroll
  for (int i = 0; i < 12; ++i) af_[i] = *(const bf16x8*)&ab[(mt * 16 + col) * AB_LD + i * 32 + kc * 8];
  const u16* LW = (const u16*)(p.ws + WS_LORA);
  const u16* W2T = LW + (size_t)(l * 2) * 256 * 64;
  const u16* A2T = LW + 65536 + (size_t)(l * 2) * 256 * 64;
  const u16* G2T = LW + 131072 + (size_t)l * 256 * 128;
  const int tk = mt * 16 + col;
  const float* fr_ = fs + tk * FS_LD;
  float rsq = 0.f;
#pragma unroll
  for (int nt = 0; nt < 4; ++nt) {
    const int c4 = h * 64 + nt * 16 + kc * 4;
    const float4 kv = *(const float4*)&fr_[256 + c4];
    const float4 ks4 = *(const float4*)&((const float*)(smem + PRM_OFF))[4 * 256 + c4];
    const float q0 = kv.x * ks4.x, q1 = kv.y * ks4.y, q2 = kv.z * ks4.z, q3 = kv.w * ks4.w;
    rsq += q0 * q0 + q1 * q1 + q2 * q2 + q3 * q3;
  }
  rsq += __shfl_xor(rsq, 16); rsq += __shfl_xor(rsq, 32);
  const float rs = rsqrtf(rsq + 1e-12f);
  float bsp = 0.f;
  u16* SC = (u16*)(p.ws + WS_SC);
  u16* Gp = (u16*)(p.ws + WS_G);
  u16* BON = (u16*)(p.ws + WS_BON);
  constexpr size_t AS = (size_t)T * 256;
  bf16x8 wq[2][12];
#define LOADW(buf, nt_) do { const int ca_ = h * 64 + ((nt_) >> 1) * 32 + (col >> 2) * 8 + ((nt_) & 1) * 4 + (col & 3);     \
    _Pragma("unroll") for (int ks = 0; ks < 2; ++ks) { \
      wq[buf][0 + ks] = *(const bf16x8*)&W2T[(size_t)ca_ * 64 + ks * 32 + kc * 8]; \
      wq[buf][2 + ks] = *(const bf16x8*)&W2T[(size_t)(256 + ca_) * 64 + ks * 32 + kc * 8]; \
      wq[buf][4 + ks] = *(const bf16x8*)&A2T[(size_t)ca_ * 64 + ks * 32 + kc * 8]; \
      wq[buf][6 + ks] = *(const bf16x8*)&A2T[(size_t)(256 + ca_) * 64 + ks * 32 + kc * 8]; } \
    _Pragma("unroll") for (int ks = 0; ks < 4; ++ks) wq[buf][8 + ks] = *(const bf16x8*)&G2T[(size_t)ca_ * 128 + ks * 32 + kc * 8]; } while (0)
  uint2 lo_[10];
  LOADW(0, 0);
#pragma unroll
  for (int nt = 0; nt < 4; ++nt) {
    if (nt + 1 < 4) LOADW((nt + 1) & 1, nt + 1);
    const int c4 = h * 64 + (nt >> 1) * 32 + kc * 8 + (nt & 1) * 4;
    f32x4 cwf = {0.f, 0.f, 0.f, 0.f}, cwb = cwf, caf = cwf, cab = cwf, cg = cwf;
#pragma unroll
    for (int ks = 0; ks < 2; ++ks) {
      cwf = __builtin_amdgcn_mfma_f32_16x16x32_bf16(wq[nt & 1][0 + ks], af_[0 + ks], cwf, 0, 0, 0);
      cwb = __builtin_amdgcn_mfma_f32_16x16x32_bf16(wq[nt & 1][2 + ks], af_[2 + ks], cwb, 0, 0, 0);
      caf = __builtin_amdgcn_mfma_f32_16x16x32_bf16(wq[nt & 1][4 + ks], af_[4 + ks], caf, 0, 0, 0);
      cab = __builtin_amdgcn_mfma_f32_16x16x32_bf16(wq[nt & 1][6 + ks], af_[6 + ks], cab, 0, 0, 0);
    }
#pragma unroll
    for (int ks = 0; ks < 4; ++ks) cg = __builtin_amdgcn_mfma_f32_16x16x32_bf16(wq[nt & 1][8 + ks], af_[8 + ks], cg, 0, 0, 0);
    const float* prm = (const float*)(smem + PRM_OFF);
    const f32x4 w0f = *(const f32x4*)&prm[0 * 256 + c4], w0b = *(const f32x4*)&prm[1 * 256 + c4];
    const f32x4 a0f = *(const f32x4*)&prm[2 * 256 + c4], a0b = *(const f32x4*)&prm[3 * 256 + c4];
    const f32x4 kks = *(const f32x4*)&prm[4 * 256 + c4], kas = *(const f32x4*)&prm[5 * 256 + c4], rkc = *(const f32x4*)&prm[6 * 256 + c4];
    const f32x4 r4 = *(const f32x4*)&fr_[c4], k4 = *(const f32x4*)&fr_[256 + c4], v4 = *(const f32x4*)&fr_[512 + c4];
    float o_r[4], o_v[4], o_a[4], o_w0[4], o_w1[4], o_k0[4], o_k1[4], o_b0[4], o_b1[4], o_g[4];
#pragma unroll
    for (int j = 0; j < 4; ++j) {
      const float r = r4[j], k = k4[j], v = v4[j];
      const float sd0 = 0.6065306597126334f * sigm(w0f[j] + cwf[j]);
      const float sd1 = 0.6065306597126334f * sigm(w0b[j] + cwb[j]);
      const float a0 = sigm(a0f[j] + caf[j]), a1 = sigm(a0b[j] + cab[j]);
      const float kkn = k * kks[j] * rs;
      const float k0 = k * (1.f + (a0 - 1.f) * kas[j]), k1 = k * (1.f + (a1 - 1.f) * kas[j]);
      bsp += r * (k0 + k1) * rkc[j];
      o_r[j] = r; o_v[j] = v; o_a[j] = -kkn; o_w0[j] = sd0; o_w1[j] = sd1; o_k0[j] = k0; o_k1[j] = k1; o_b0[j] = kkn * a0; o_b1[j] = kkn * a1; o_g[j] = cg[j];
    }
#define PK4(a_) make_uint2(pack2(a_[0], a_[1]), pack2(a_[2], a_[3]))
    if ((nt & 1) == 0) {
      lo_[0] = PK4(o_r); lo_[1] = PK4(o_v); lo_[2] = PK4(o_a); lo_[3] = PK4(o_w0); lo_[4] = PK4(o_w1);
      lo_[5] = PK4(o_k0); lo_[6] = PK4(o_k1); lo_[7] = PK4(o_b0); lo_[8] = PK4(o_b1); lo_[9] = PK4(o_g);
    } else {
      const size_t o = (size_t)(t0 + tk) * 256 + h * 64 + (nt >> 1) * 32 + kc * 8;
#define ST8(dst, a_, li) do { const uint2 hi_ = PK4(a_); *(uint4*)&(dst)[o] = make_uint4(lo_[li].x, lo_[li].y, hi_.x, hi_.y); } while (0)
      ST8(SC + 0 * AS, o_r, 0); ST8(SC + 1 * AS, o_v, 1); ST8(SC + 2 * AS, o_a, 2); ST8(SC + 3 * AS, o_w0, 3); ST8(SC + 4 * AS, o_w1, 4);
      ST8(SC + 5 * AS, o_k0, 5); ST8(SC + 6 * AS, o_k1, 6); ST8(SC + 7 * AS, o_b0, 7); ST8(SC + 8 * AS, o_b1, 8); ST8(Gp, o_g, 9);
#undef ST8
    }
  }
  bsp += __shfl_xor(bsp, 16); bsp += __shfl_xor(bsp, 32);
#pragma unroll
  for (int pp = 0; pp < 2; ++pp) {
    const int c8 = h * 64 + pp * 32 + kc * 8;
    const f32x4 va = *(const f32x4*)&fr_[512 + c8], vb = *(const f32x4*)&fr_[512 + c8 + 4];
    float oa[4], ob2[4];
#pragma unroll
    for (int j = 0; j < 4; ++j) { oa[j] = bsp * va[j]; ob2[j] = bsp * vb[j]; }
    const uint2 l2 = PK4(oa), h2 = PK4(ob2);
    *(uint4*)&BON[(size_t)(t0 + tk) * 256 + c8] = make_uint4(l2.x, l2.y, h2.x, h2.y);
  }
#undef PK4
#undef LOADW
  __syncthreads();
}

DI void conv_item(const P& p, int l, int item) {
  float* hb = (float*)smem;
  float* ob = hb + 62 * 256;
  const int tid = otid();
  const int t0 = item * 32;
  int L, n0;
  if (t0 < TX) { L = 2048; n0 = t0 & 2047; } else { L = 256; n0 = (t0 - TX) & 255; }
  const u16* FC = (const u16*)(p.ws + WS_FC);
  const int c = tid & 255, ph = tid >> 8;
  {
    uint4 vv_[4], gg_[4];
#pragma unroll
    for (int q = 0; q < 4; ++q) {
      const int idx = q * NTHR + tid;
      const int rr = idx >> 5, cq = (idx & 31) * 8;
      const int n = n0 + rr - 15;
      const bool ok = rr < 62 && n >= 0 && n < L;
      const size_t row = ok ? (size_t)(t0 + rr - 15) : (size_t)t0;
      vv_[q] = *(const uint4*)&FC[row * 512 + cq]; gg_[q] = *(const uint4*)&FC[row * 512 + 256 + cq];
    }
#pragma unroll
    for (int q = 0; q < 4; ++q) {
      const int idx = q * NTHR + tid;
      const int rr = idx >> 5, cq = (idx & 31) * 8;
      const int n = n0 + rr - 15;
      const bool ok = n >= 0 && n < L;
      const unsigned vw[4] = {vv_[q].x, vv_[q].y, vv_[q].z, vv_[q].w}, gw[4] = {gg_[q].x, gg_[q].y, gg_[q].z, gg_[q].w};
      f32x4 h0 = {0.f, 0.f, 0.f, 0.f}, h1 = h0;
      if (ok) {
        h0[0] = blo(vw[0]) * sigm(blo(gw[0])); h0[1] = bhi(vw[0]) * sigm(bhi(gw[0])); h0[2] = blo(vw[1]) * sigm(blo(gw[1])); h0[3] = bhi(vw[1]) * sigm(bhi(gw[1]));
        h1[0] = blo(vw[2]) * sigm(blo(gw[2])); h1[1] = bhi(vw[2]) * sigm(bhi(gw[2])); h1[2] = blo(vw[3]) * sigm(blo(gw[3])); h1[3] = bhi(vw[3]) * sigm(bhi(gw[3]));
      }
      if (rr < 62) { *(f32x4*)&hb[rr * 256 + cq] = h0; *(f32x4*)&hb[rr * 256 + cq + 4] = h1; }
    }
  }
  __syncthreads();
  {
    float wreg[31];
#pragma unroll
    for (int w = 0; w < 31; ++w) wreg[w] = p.dw_w[(size_t)(l * 31 + w) * 256 + c];
    const float bias = p.dw_b[l * 256 + c];
    for (int pp = 0; pp < 16; ++pp) {
      const int pos = ph * 16 + pp;
      float a = bias;
#pragma unroll
      for (int w = 0; w < 31; ++w) a += hb[(pos + w) * 256 + c] * wreg[w];
      ob[pos * 256 + c] = a;
    }
  }
  __syncthreads();
  {
    const int lane = tid & 63, w = tid >> 6;
    u16* CAT = (u16*)(p.ws + WS_H);
    const float4 g4 = *(const float4*)&p.cln_g[l * 256 + lane * 4];
    const float4 b4 = *(const float4*)&p.cln_b[l * 256 + lane * 4];
#pragma unroll
    for (int q = 0; q < 4; ++q) {
      const int pos = w * 4 + q;
      const float4 v = *(const float4*)&ob[pos * 256 + lane * 4];
      const float mu = wave_sum(v.x + v.y + v.z + v.w) * (1.f / 256.f);
      const float d0 = v.x - mu, d1 = v.y - mu, d2 = v.z - mu, d3 = v.w - mu;
      const float var = wave_sum(d0 * d0 + d1 * d1 + d2 * d2 + d3 * d3) * (1.f / 256.f);
      const float rs = rsqrtf(var + 1e-5f);
      float y0 = d0 * rs * g4.x + b4.x, y1 = d1 * rs * g4.y + b4.y, y2 = d2 * rs * g4.z + b4.z, y3 = d3 * rs * g4.w + b4.w;
      y0 *= sigm(y0); y1 *= sigm(y1); y2 *= sigm(y2); y3 *= sigm(y3);
      uint2 o; o.x = pack2(y0, y1); o.y = pack2(y2, y3);
      *(uint2*)&CAT[(size_t)(t0 + pos) * 1024 + 256 + lane * 4] = o;
    }
  }
  __syncthreads();
}

DI void prepconv_phase(const P& p, int l, int rep) {
  const int nprep = T / 32, nconv = (l == 0 ? T : TX) / 32;
  unsigned* ctr = (unsigned*)(p.ws + WS_MISC) + 12 + l + 2 * rep;
  int* slot = (int*)(smem + LDS_CTL);
  {
    float* prm = (float*)(smem + PRM_OFF);
    for (int i = otid(); i < 7 * 256; i += NTHR) {
      const int a = i >> 8, c = i & 255;
      prm[i] = a < 2 ? p.w0[(l * 2 + a) * 256 + c] : a < 4 ? p.a0[(l * 2 + (a - 2)) * 256 + c] : a == 4 ? p.kk[l * 256 + c] : a == 5 ? p.ka[l * 256 + c] : p.rk[l * 256 + c];
    }
    __syncthreads();
  }
  int it = obid();
  while (it < nprep + nconv) {
    unsigned nx = 0u;
    if (otid() == 0) nx = atomicAdd(ctr, 1u);
    if (it < nprep) { if (!(rep && MIXPROBE == 4)) rwkv_prep_item(p, l, it); }
    else { if (!(rep && MIXPROBE == 3)) conv_item(p, l, it - nprep); }
    if (otid() == 0) *slot = (int)(gridDim.x + nx);
    __syncthreads();
    it = *slot;
    __syncthreads();
  }
}

DI int scan_row(int b, int dir, int gs) {
  if (dir == 0) return gs < 256 ? TX + b * 256 + gs : b * 2048 + (gs - 256);
  return gs < 256 ? TX + b * 256 + (255 - gs) : b * 2048 + (2047 - (gs - 256));
}

DI float allred8(float v) {
  v += dppx<0xB1>(v); v += dppx<0x4E>(v); v += dppx<0x141>(v);
  return v;
}
typedef float f2 __attribute__((ext_vector_type(2)));
constexpr int SST = 320;
constexpr int SOFF_V = 16 * SST;
constexpr int SOFF_BK = SOFF_V + 512;
constexpr int SBUF = SOFF_BK + 64;
struct ScanStep { f2 a[4], w[4], r[4], b[4], k[4]; };
DI void scan_block(const P& p, int sb) {
  const int tid = otid();
  const int chain = sb >> 1, rh = sb & 1, b = chain >> 3, h = (chain >> 1) & 3, dir = chain & 1;
  float* stg = (float*)smem;
  float* ybuf = stg + 2 * SBUF;
  const u16* SC = (const u16*)(p.ws + WS_SC);
  constexpr size_t AS = (size_t)T * 256;
  const bool is_comp = tid < 256;
#define LO(u) __uint_as_float((u) << 16)
#define HI(u) __uint_as_float((u) & 0xffff0000u)
  if (is_comp) {
    const int lane = tid & 63, cw = tid >> 6, jg = lane & 7, rl = cw * 8 + (lane >> 3);
    f2 S[4];
#pragma unroll
    for (int i = 0; i < 4; ++i) S[i] = (f2){0.f, 0.f};
    __syncthreads();
    for (int ch = 0; ch < 144; ++ch) {
      const float* st = stg + (ch & 1) * SBUF;
      float* yb = (jg == 0) ? (ybuf + (ch & 1) * 512 + rl) : (ybuf + 1024 + tid);
#define SLD(R, s) do { const float* d_ = st + (s) * SST + jg * 8; \
      { const float4 x_ = *(const float4*)&d_[0], y_ = *(const float4*)&d_[4]; R.a[0] = (f2){x_.x, x_.y}; R.a[1] = (f2){x_.z, x_.w}; R.a[2] = (f2){y_.x, y_.y}; R.a[3] = (f2){y_.z, y_.w}; } \
      { const float4 x_ = *(const float4*)&d_[64], y_ = *(const float4*)&d_[68]; R.w[0] = (f2){x_.x, x_.y}; R.w[1] = (f2){x_.z, x_.w}; R.w[2] = (f2){y_.x, y_.y}; R.w[3] = (f2){y_.z, y_.w}; } \
      { const float4 x_ = *(const float4*)&d_[128], y_ = *(const float4*)&d_[132]; R.r[0] = (f2){x_.x, x_.y}; R.r[1] = (f2){x_.z, x_.w}; R.r[2] = (f2){y_.x, y_.y}; R.r[3] = (f2){y_.z, y_.w}; } \
      { const float4 x_ = *(const float4*)&d_[192], y_ = *(const float4*)&d_[196]; R.b[0] = (f2){x_.x, x_.y}; R.b[1] = (f2){x_.z, x_.w}; R.b[2] = (f2){y_.x, y_.y}; R.b[3] = (f2){y_.z, y_.w}; } \
      { const float4 x_ = *(const float4*)&d_[256], y_ = *(const float4*)&d_[260]; R.k[0] = (f2){x_.x, x_.y}; R.k[1] = (f2){x_.z, x_.w}; R.k[2] = (f2){y_.x, y_.y}; R.k[3] = (f2){y_.z, y_.w}; } } while (0)
      float vv[16]; float bk[32];
#pragma unroll
      for (int q = 0; q < 4; ++q) { const float4 x_ = *(const float4*)&st[SOFF_V + rl * 16 + q * 4]; vv[q * 4] = x_.x; vv[q * 4 + 1] = x_.y; vv[q * 4 + 2] = x_.z; vv[q * 4 + 3] = x_.w; }
#pragma unroll
      for (int q = 0; q < 8; ++q) { const float4 x_ = *(const float4*)&st[SOFF_BK + q * 4]; bk[q * 4] = x_.x; bk[q * 4 + 1] = x_.y; bk[q * 4 + 2] = x_.z; bk[q * 4 + 3] = x_.w; }
      ScanStep cur, nxt;
      SLD(cur, 0);
#pragma unroll
      for (int s = 0; s < 16; ++s) {
        if (s + 1 < 16) SLD(nxt, s + 1);
        __builtin_amdgcn_sched_barrier(0);
        f2 t = S[0] * cur.a[0]; t = S[1] * cur.a[1] + t; t = S[2] * cur.a[2] + t; t = S[3] * cur.a[3] + t;
        f2 u = S[0] * cur.r[0]; u = S[1] * cur.r[1] + u; u = S[2] * cur.r[2] + u; u = S[3] * cur.r[3] + u;
        float sa = t.x + t.y, yp = u.x + u.y;
        sa = allred8(sa);
        yp = allred8(yp);
        const float v = vv[s];
        const float y = yp + sa * bk[2 * s] + v * bk[2 * s + 1];
        const f2 sa2 = (f2){sa, sa}, v2 = (f2){v, v};
#pragma unroll
        for (int i = 0; i < 4; ++i) S[i] = S[i] * cur.w[i] + (sa2 * cur.b[i] + v2 * cur.k[i]);
        yb[s * 32] = y;
        if (s + 1 < 16) cur = nxt;
      }
#undef SLD
      __syncthreads();
    }
    __syncthreads();
  } else {
    const int t2 = tid - 256, s_ = t2 >> 4, q_ = t2 & 15;
    const u16* Rp = SC, *Vp = SC + AS, *Ap = SC + 2 * AS, *Wp = SC + (3 + dir) * AS, *Kp = SC + (5 + dir) * AS, *Bp = SC + (7 + dir) * AS;
    u16* Y = (u16*)(p.ws + WS_Y) + (size_t)dir * AS;
    const int choff = h * 64 + 4 * q_;
    uint2 prA, pvA, paA, pwA, pkA, pbA, prB, pvB, paB, pwB, pkB, pbB;
#define SCAN_ISSUE(X, ch) do { const size_t o_ = (size_t)scan_row(b, dir, (ch) * 16 + s_) * 256 + choff; \
    pr##X = *(const uint2*)&Rp[o_]; pv##X = *(const uint2*)&Vp[o_]; pa##X = *(const uint2*)&Ap[o_]; \
    pw##X = *(const uint2*)&Wp[o_]; pk##X = *(const uint2*)&Kp[o_]; pb##X = *(const uint2*)&Bp[o_]; } while (0)
#define SCAN_COMMIT(X, bufi) do { float* d0_ = stg + (bufi) * SBUF; float* d_ = d0_ + s_ * SST; \
    const float4 r4 = make_float4(LO(pr##X.x), HI(pr##X.x), LO(pr##X.y), HI(pr##X.y)); \
    const float4 w4 = make_float4(__expf(-LO(pw##X.x)), __expf(-HI(pw##X.x)), __expf(-LO(pw##X.y)), __expf(-HI(pw##X.y))); \
    const float4 k4 = make_float4(LO(pk##X.x), HI(pk##X.x), LO(pk##X.y), HI(pk##X.y)); \
    const float4 b4 = make_float4(LO(pb##X.x), HI(pb##X.x), LO(pb##X.y), HI(pb##X.y)); \
    *(float4*)&d_[4 * q_] = make_float4(LO(pa##X.x), HI(pa##X.x), LO(pa##X.y), HI(pa##X.y)); \
    *(float4*)&d_[64 + 4 * q_] = w4; \
    *(float4*)&d_[128 + 4 * q_] = make_float4(w4.x * r4.x, w4.y * r4.y, w4.z * r4.z, w4.w * r4.w); \
    *(float4*)&d_[192 + 4 * q_] = b4; \
    *(float4*)&d_[256 + 4 * q_] = k4; \
    if ((q_ >> 3) == rh) { float* dv_ = d0_ + SOFF_V + 4 * (q_ & 7) * 16 + s_; dv_[0] = LO(pv##X.x); dv_[16] = HI(pv##X.x); dv_[32] = LO(pv##X.y); dv_[48] = HI(pv##X.y); } \
    float br_ = b4.x * r4.x + b4.y * r4.y + b4.z * r4.z + b4.w * r4.w; \
    float kr_ = k4.x * r4.x + k4.y * r4.y + k4.z * r4.z + k4.w * r4.w; \
    br_ = allred16(br_); kr_ = allred16(kr_); \
    if (q_ == 0) *(float2*)&d0_[SOFF_BK + 2 * s_] = make_float2(br_, kr_); } while (0)
#define SCAN_YSTORE(ch) do { const float* yb_ = ybuf + ((ch) & 1) * 512; \
    const float2 yv_ = *(const float2*)&yb_[s_ * 32 + 2 * q_]; \
    const int row_ = scan_row(b, dir, (ch) * 16 + s_); \
    *(unsigned*)&Y[(size_t)row_ * 256 + h * 64 + rh * 32 + 2 * q_] = pack2(yv_.x, yv_.y); } while (0)
    SCAN_ISSUE(A, 0);
    SCAN_COMMIT(A, 0);
    SCAN_ISSUE(B, 1);
    __syncthreads();
    for (int ch = 0; ch < 144; ch += 2) {
      SCAN_COMMIT(B, 1);
      if (ch + 2 < 144) SCAN_ISSUE(A, ch + 2);
      if (ch > 0) SCAN_YSTORE(ch - 1);
      __syncthreads();
      if (ch + 2 < 144) SCAN_COMMIT(A, 0);
      if (ch + 3 < 144) SCAN_ISSUE(B, ch + 3);
      SCAN_YSTORE(ch);
      __syncthreads();
    }
    SCAN_YSTORE(143);
    __syncthreads();
#undef SCAN_ISSUE
#undef SCAN_COMMIT
#undef SCAN_YSTORE
  }
}

#define MFMA32(a, b, c) __builtin_amdgcn_mfma_f32_32x32x16_bf16((a), (b), (c), 0, 0, 0)
constexpr int ATT_BUF = 36864;
DI void attn_item(const P& p, int l, int item) {
  const int tid = otid(), lane = tid & 63, wave = tid >> 6, m = wave >> 2, qw = wave & 3, r = lane & 31, hh = lane >> 5;
  int qrow0, b, h, key0, nk;
  if (item < 512) { b = item >> 6; h = (item >> 4) & 3; qrow0 = b * 2048 + (item & 15) * 128; key0 = 0; nk = 2304; }
  else { const int it = item - 512; b = it >> 3; h = (it >> 1) & 3; qrow0 = TX + b * 256 + (it & 1) * 128; key0 = 2048; nk = 256; }
  const u16* Q = (const u16*)(p.ws + WS_Q);
  const u16* KK = (const u16*)(p.ws + WS_KK) + ((size_t)b * 2304 + key0) * 512 + h * 128;
  const u16* VT = (const u16*)(p.ws + WS_VT) + ((size_t)(b * 4 + h) * 128) * 2304 + key0;
  bf16x8 qf[4];
  {
    const u16* qp = Q + (size_t)(qrow0 + qw * 32 + r) * 512 + h * 128 + m * 64 + hh * 8;
#pragma unroll
    for (int ks = 0; ks < 4; ++ks) qf[ks] = *(const bf16x8*)&qp[ks * 16];
  }
  uint4 g0 = make_uint4(0u, 0u, 0u, 0u), g1 = g0, g2 = g0, g3 = g0;
  const int ck0 = tid, ck1 = tid + 512;
  const int kdst0 = (ck0 >> 9) * 9216 + ((ck0 >> 3) & 63) * 144 + (ck0 & 7) * 16;
  const int kdst1 = (ck1 >> 9) * 9216 + ((ck1 >> 3) & 63) * 144 + (ck1 & 7) * 16;
  const size_t ksrc0 = (size_t)((ck0 >> 3) & 63) * 512 + (ck0 >> 9) * 64 + (ck0 & 7) * 8;
  const size_t ksrc1 = (size_t)((ck1 >> 3) & 63) * 512 + (ck1 >> 9) * 64 + (ck1 & 7) * 8;
  const int vdst0 = 18432 + (ck0 >> 3) * 144 + (ck0 & 7) * 16;
  const int vdst1 = 18432 + (ck1 >> 3) * 144 + (ck1 & 7) * 16;
  const size_t vsrc0 = (size_t)(ck0 >> 3) * 2304 + (ck0 & 7) * 8;
  const size_t vsrc1 = (size_t)(ck1 >> 3) * 2304 + (ck1 & 7) * 8;
#define ATT_LOAD(t) do { const u16* kp_ = KK + (size_t)(t) * 64 * 512; const u16* vp_ = VT + (t) * 64; \
    g0 = *(const uint4*)&kp_[ksrc0]; g1 = *(const uint4*)&kp_[ksrc1]; \
    g2 = *(const uint4*)&vp_[vsrc0]; g3 = *(const uint4*)&vp_[vsrc1]; } while (0)
#define ATT_STORE(bi) do { unsigned char* bb_ = smem + (bi) * ATT_BUF; \
    *(uint4*)(bb_ + kdst0) = g0; *(uint4*)(bb_ + kdst1) = g1; \
    *(uint4*)(bb_ + vdst0) = g2; *(uint4*)(bb_ + vdst1) = g3; } while (0)
#define ATT_QK(kb) do { _Pragma("unroll") for (int ks = 0; ks < 4; ++ks) { \
      const bf16x8 a0_ = *(const bf16x8*)((kb) + r * 144 + ks * 32 + hh * 16); \
      const bf16x8 a1_ = *(const bf16x8*)((kb) + (32 + r) * 144 + ks * 32 + hh * 16); \
      s0 = MFMA32(a0_, qf[ks], s0); s1 = MFMA32(a1_, qf[ks], s1); } } while (0)
#define ATT_PV1(vb, kt, s, PF) do { _Pragma("unroll") for (int nt = 0; nt < 4; ++nt) { \
        const unsigned char* vp_ = (vb) + (nt * 32 + r) * 144 + ((kt) * 32 + 16 * (s) + 4 * hh) * 2; \
        const s16x4 lo_ = *(const s16x4*)vp_; const s16x4 hi_ = *(const s16x4*)(vp_ + 16); \
        const bf16x8 vf_ = __builtin_shufflevector(lo_, hi_, 0, 1, 2, 3, 4, 5, 6, 7); \
        o[nt] = MFMA32(vf_, PF, o[nt]); } } while (0)
#define ATT_PV(vb) do { ATT_PV1(vb, 0, 0, pf0); ATT_PV1(vb, 0, 1, pf1); ATT_PV1(vb, 1, 0, pf2); ATT_PV1(vb, 1, 1, pf3); } while (0)
  const int ntile = nk / 64;
  ATT_LOAD(0);
  ATT_STORE(0);
  __syncthreads();
  float mrun;
  {
    f32x16 s0, s1;
#pragma unroll
    for (int j = 0; j < 16; ++j) { s0[j] = 0.f; s1[j] = 0.f; }
    const unsigned char* kb = smem + m * 9216;
    ATT_QK(kb);
    float mx = s0[0];
#pragma unroll
    for (int j = 1; j < 16; ++j) mx = fmaxf(mx, s0[j]);
#pragma unroll
    for (int j = 0; j < 16; ++j) mx = fmaxf(mx, s1[j]);
    mrun = fmaxf(mx, __shfl_xor(mx, 32));
  }
  f32x16 o[4];
#pragma unroll
  for (int i = 0; i < 4; ++i)
#pragma unroll
    for (int j = 0; j < 16; ++j) o[i][j] = 0.f;
  float lrun = 0.f;
  bf16x8 pf0, pf1, pf2, pf3;
#pragma unroll
  for (int j = 0; j < 8; ++j) { pf0[j] = 0; pf1[j] = 0; pf2[j] = 0; pf3[j] = 0; }
  for (int t = 0; t <= ntile; ++t) {
    if (t + 1 < ntile) ATT_LOAD(t + 1);
    if (m == 1 && t > 0) { const unsigned char* vb = smem + ((t - 1) % 3) * ATT_BUF + 18432; ATT_PV(vb); }
    if (t < ntile) {
      const unsigned char* kb = smem + (t % 3) * ATT_BUF + m * 9216;
      f32x16 s0, s1;
      const float nm = -mrun;
#pragma unroll
      for (int j = 0; j < 16; ++j) { s0[j] = nm; s1[j] = nm; }
      ATT_QK(kb);
      float mx = s0[0];
#pragma unroll
      for (int j = 1; j < 16; ++j) mx = fmaxf(mx, s0[j]);
#pragma unroll
      for (int j = 0; j < 16; ++j) mx = fmaxf(mx, s1[j]);
      if (__builtin_amdgcn_ballot_w64(mx > 8.f) != 0ull) {
        const float mo = fmaxf(mx, __shfl_xor(mx, 32));
        const float delta = fmaxf(mo, 0.f);
        const float alpha = __builtin_amdgcn_exp2f(-delta);
        mrun += delta; lrun *= alpha;
#pragma unroll
        for (int i = 0; i < 4; ++i)
#pragma unroll
          for (int j = 0; j < 16; ++j) o[i][j] *= alpha;
#pragma unroll
        for (int j = 0; j < 16; ++j) { s0[j] -= delta; s1[j] -= delta; }
      }
      float ls = 0.f;
#pragma unroll
      for (int j = 0; j < 16; ++j) { s0[j] = __builtin_amdgcn_exp2f(s0[j]); ls += s0[j]; }
#pragma unroll
      for (int j = 0; j < 16; ++j) { s1[j] = __builtin_amdgcn_exp2f(s1[j]); ls += s1[j]; }
      lrun += ls;
#pragma unroll
      for (int j = 0; j < 8; ++j) { pf0[j] = (short)f2bf(s0[j]); pf1[j] = (short)f2bf(s0[8 + j]); pf2[j] = (short)f2bf(s1[j]); pf3[j] = (short)f2bf(s1[8 + j]); }
    }
    if (m == 0 && t < ntile) { const unsigned char* vb = smem + (t % 3) * ATT_BUF + 18432; ATT_PV(vb); }
    if (t + 1 < ntile) ATT_STORE((t + 1) % 3);
    __syncthreads();
  }
  const float lt = lrun + __shfl_xor(lrun, 32);
  const float inv = 1.f / lt;
  float* ob = (float*)smem;
  if (m == 1) {
#pragma unroll
    for (int nt = 0; nt < 4; ++nt)
#pragma unroll
      for (int j = 0; j < 16; ++j) ob[((qw * 4 + nt) * 16 + j) * 64 + lane] = o[nt][j] * inv;
  }
  __syncthreads();
  if (m == 0) {
    const float* mf = (const float*)(p.ws + WS_MISC);
    const float lamv = mf[l], li = mf[2 + l];
    float ss = 0.f;
#pragma unroll
    for (int nt = 0; nt < 4; ++nt)
#pragma unroll
      for (int j = 0; j < 16; ++j) {
        const float dv = o[nt][j] * inv - lamv * ob[((qw * 4 + nt) * 16 + j) * 64 + lane];
        o[nt][j] = dv;
        ss += dv * dv;
      }
    ss += __shfl_xor(ss, 32);
    const float rs = rsqrtf(ss * (1.f / 128.f) + 1e-5f) * (1.f - li);
    u16* CAT = (u16*)(p.ws + WS_H) + (size_t)(qrow0 + qw * 32 + r) * 1024 + 512 + h * 128;
    const float* gp = p.dng + l * 128;
#pragma unroll
    for (int nt = 0; nt < 4; ++nt) {
      uint2 ch[4];
#pragma unroll
      for (int g = 0; g < 4; ++g) {
        const int vd = nt * 32 + 8 * g + 4 * hh;
        const float4 g4 = *(const float4*)&gp[vd];
        ch[g].x = pack2(o[nt][4 * g + 0] * rs * g4.x, o[nt][4 * g + 1] * rs * g4.y);
        ch[g].y = pack2(o[nt][4 * g + 2] * rs * g4.z, o[nt][4 * g + 3] * rs * g4.w);
      }
#pragma unroll
      for (int q = 0; q < 2; ++q) {
        const uint2 snd = hh ? ch[2 * q] : ch[2 * q + 1];
        const uint2 rcv = make_uint2((unsigned)__shfl_xor((int)snd.x, 32), (unsigned)__shfl_xor((int)snd.y, 32));
        const uint4 o4 = hh ? make_uint4(rcv.x, rcv.y, ch[2 * q + 1].x, ch[2 * q + 1].y) : make_uint4(ch[2 * q].x, ch[2 * q].y, rcv.x, rcv.y);
        *(uint4*)&CAT[nt * 32 + 16 * q + 8 * hh] = o4;
      }
    }
  }
  __syncthreads();
#undef ATT_LOAD
#undef ATT_STORE
#undef ATT_QK
#undef ATT_PV
#undef ATT_PV1
}

DI void mixer_phase(const P& p, int l, int rep) {
  if (!(rep && MIXPROBE == 1)) for (int sb = obid(); sb < 128; sb += gridDim.x) scan_block(p, sb);
  if (rep && MIXPROBE == 2) return;
  const int nitems = l == 0 ? 576 : 512;
  unsigned* ctr = (unsigned*)(p.ws + WS_MISC) + 8 + l + 2 * rep;
  int* slot = (int*)(smem + LDS_CTL);
  const int nstat = (int)gridDim.x > 128 ? (int)gridDim.x - 128 : 0;
  int it;
  if (obid() >= 128) it = obid() - 128;
  else {
    if (otid() == 0) *slot = nstat + (int)atomicAdd(ctr, 1u);
    __syncthreads();
    it = *slot;
    __syncthreads();
  }
  while (it < nitems) {
    unsigned nx = 0u;
    if (otid() == 0) nx = atomicAdd(ctr, 1u);
    attn_item(p, l, it);
    if (otid() == 0) *slot = nstat + (int)nx;
    __syncthreads();
    it = *slot;
    __syncthreads();
  }
}

DI void finish_phase(const P& p, int l, int rows) {
  const int lane = otid() & 63, w = otid() >> 6;
  const u16* Y = (const u16*)(p.ws + WS_Y);
  const u16* Gp = (const u16*)(p.ws + WS_G);
  const u16* BON = (const u16*)(p.ws + WS_BON);
  u16* CAT = (u16*)(p.ws + WS_H);
  constexpr size_t AS = (size_t)T * 256;
  const float4 g4 = *(const float4*)&p.ln_g[l * 256 + lane * 4];
  const float4 b4 = *(const float4*)&p.ln_b[l * 256 + lane * 4];
  for (int row = obid() * 8 + w; row < rows; row += gridDim.x * 8) {
    const size_t o = (size_t)row * 256 + lane * 4;
    const uint2 yf = *(const uint2*)&Y[o], yb = *(const uint2*)&Y[AS + o];
    const uint2 gg = *(const uint2*)&Gp[o], bo = *(const uint2*)&BON[o];
    float y0 = LO(yf.x) + LO(yb.x), y1 = HI(yf.x) + HI(yb.x), y2 = LO(yf.y) + LO(yb.y), y3 = HI(yf.y) + HI(yb.y);
    float s = y0 + y1 + y2 + y3;
    s = allred16(s);
    const float mu = s * (1.f / 64.f);
    y0 -= mu; y1 -= mu; y2 -= mu; y3 -= mu;
    float vs = y0 * y0 + y1 * y1 + y2 * y2 + y3 * y3;
    vs = allred16(vs);
    const float rs = rsqrtf(vs * (1.f / 64.f) + 64e-5f);
    const float o0 = (y0 * rs * g4.x + b4.x + LO(bo.x)) * LO(gg.x);
    const float o1 = (y1 * rs * g4.y + b4.y + HI(bo.x)) * HI(gg.x);
    const float o2 = (y2 * rs * g4.z + b4.z + LO(bo.y)) * LO(gg.y);
    const float o3 = (y3 * rs * g4.w + b4.w + HI(bo.y)) * HI(gg.y);
    uint2 ov; ov.x = pack2(o0, o1); ov.y = pack2(o2, o3);
    *(uint2*)&CAT[(size_t)row * 1024 + lane * 4] = ov;
  }
}


#define XB_TMO      128
#define XB_XCNT(j)  (256  + 64 * (j))
#define XB_XSUB(j)  (1280 + 64 * (j))
#define XB_XGEN(j)  (2304 + 64 * (j))
#define XB_TOP      3328
#define XB_TOPGEN   3392
#define XB_SPIN_CAP (1u << 20)
DI unsigned xb_ld(unsigned* p) { return __hip_atomic_load(p, __ATOMIC_RELAXED, __HIP_MEMORY_SCOPE_AGENT); }
DI unsigned xb_add(unsigned* p, unsigned v) { return __hip_atomic_fetch_add(p, v, __ATOMIC_RELAXED, __HIP_MEMORY_SCOPE_AGENT); }
DI unsigned xb_xcc_id() { return (unsigned)__builtin_amdgcn_s_getreg((3 << 11) | 20) & 0xFu; }
#define XB_SPIN(cond, bar) do { unsigned _sp = 0; while (cond) { __builtin_amdgcn_s_sleep(1); \
    if ((++_sp & 255u) == 0u) { if (xb_ld(&(bar)[XB_TMO])) break; if (_sp > XB_SPIN_CAP) { atomicAdd(&(bar)[XB_TMO], 1u); break; } } } } while (0)
struct XcdBarrier { unsigned* bar; unsigned x; volatile LAS unsigned* st; };
DI XcdBarrier xcd_barrier_post(unsigned* bar, volatile LAS unsigned* st) {
  XcdBarrier b; b.bar = bar; b.x = xb_xcc_id(); b.st = st;
  if (threadIdx.x == 0) (void)xb_add(&bar[XB_XCNT(b.x)], 1u);
  return b;
}
DI void xcd_barrier_complete(unsigned* bar, unsigned x, unsigned& nloc, unsigned& nx) {
  const unsigned G = gridDim.x * gridDim.y * gridDim.z;
  unsigned sum, cnt, mine, sp = 0u;
  for (;;) {
    sum = 0u; cnt = 0u; mine = 0u;
#pragma unroll
    for (unsigned j = 0; j < 16; ++j) { const unsigned c = xb_ld(&bar[XB_XCNT(j)]); sum += c; cnt += (c > 0u) ? 1u : 0u; mine = (j == x) ? c : mine; }
    if (sum == G) break;
    __builtin_amdgcn_s_sleep(1);
    if ((++sp & 255u) == 0u) { if (xb_ld(&bar[XB_TMO])) break; if (sp > XB_SPIN_CAP) { atomicAdd(&bar[XB_TMO], 1u); break; } }
  }
  nloc = mine > 0u ? mine : 1u; nx = cnt > 0u ? cnt : 1u;
}
DI void xcd_barrier(const XcdBarrier& b) {
  asm volatile("s_waitcnt vmcnt(0)" ::: "memory");
  __syncthreads();
  if (threadIdx.x == 0) {
    unsigned* bar = b.bar;
    __builtin_amdgcn_s_waitcnt(0);
    unsigned nloc = b.st[0], nx = b.st[1];
    if (nloc == 0u) { xcd_barrier_complete(bar, b.x, nloc, nx); b.st[0] = nloc; b.st[1] = nx; }
    const unsigned old = xb_add(&bar[XB_XSUB(b.x)], 1u);
    const unsigned gen = old / nloc;
    if (old + 1u == (gen + 1u) * nloc) {
      __builtin_amdgcn_fence(__ATOMIC_RELEASE, "agent");
      asm volatile("s_waitcnt vmcnt(0)" ::: "memory");
      const unsigned og = xb_add(&bar[XB_TOP], 1u);
      const unsigned tg = og / nx;
      if (og + 1u == (tg + 1u) * nx) xb_add(&bar[XB_TOPGEN], 1u);
      else XB_SPIN(xb_ld(&bar[XB_TOPGEN]) == tg, bar);
      __builtin_amdgcn_fence(__ATOMIC_ACQUIRE, "agent");
      xb_add(&bar[XB_XGEN(b.x)], 1u);
      asm volatile("s_waitcnt vmcnt(0)" ::: "memory");
    } else {
      XB_SPIN(xb_ld(&bar[XB_XGEN(b.x)]) == gen, bar);
      __builtin_amdgcn_fence(__ATOMIC_ACQUIRE, "agent");
      asm volatile("s_waitcnt vmcnt(0)" ::: "memory");
    }
  }
  __syncthreads();
}

constexpr int NPHASE = 26;
#ifndef REPMASK
#define REPMASK 0
#endif
#ifndef SYNCX
#define SYNCX 0
#endif
__global__ void __launch_bounds__(NTHR) mega(P p) {
  cg::grid_group grid = cg::this_grid();
  if (p.ph_hi > 1000) grid.sync();
  volatile LAS unsigned* stw = (volatile LAS unsigned*)((LAS unsigned char*)smem + LDS_CTL + 16);
  if (threadIdx.x < 4) stw[threadIdx.x] = 0u;
  __syncthreads();
  const XcdBarrier xb = xcd_barrier_post((unsigned*)(p.ws + WS_BAR), stw);
#define GSYNC() xcd_barrier(xb)
  const u16* H = (const u16*)(p.ws + WS_H);
  const u16* ACT = (const u16*)(p.ws + WS_ACT);
  const u16* WIN = (const u16*)(p.ws + WS_WIN);
  const u16* WOUT = (const u16*)(p.ws + WS_WOUT);
  const u16* WMIN = (const u16*)(p.ws + WS_MIN);
  const u16* WMOUT = (const u16*)(p.ws + WS_MOUT);
  for (int ph = p.ph_lo; ph < p.ph_hi; ++ph) {
    if (ph == 0) {
      prep_phase(p, 0);
    } else if (ph == 25) {
      final_phase(p);
    } else {
      const int l = (ph - 1) / 12, s = (ph - 1) % 12;
      const int Mx = (l == 1) ? TX : T;
      float* xo = p.out;
      u16* ACTw = (u16*)(p.ws + WS_ACT);
      for (int rep = 0; rep < 1 + ((REPMASK >> s) & 1); ++rep) {
      switch (s) {
        case 0: if (rep == 0 && l == 1) prep_phase(p, 1); norm_phase(p, l, 0, 0, l == 0, T, (l == 1 && rep == 0) ? 8 : 0); break;
        case 1: gemm_phase(Gemm{H, WIN, T, 5632, 1024}, EpiSwiglu{ACTw}); break;
        case 2: gemm_phase(Gemm{ACT, WOUT, T, 1024, 2816}, EpiResid{xo, p.ws, l, 2, 1, 1, l == 0 ? p.x : (const float*)xo}, TX, 8); break;
        case 3: norm_phase(p, l, 1, 3, false, T, rep == 0 ? 8 : 0, l == 0); break;
        case 4: gemm_phase(Gemm{H, WMIN, T, PINP, 1024}, EpiMix{p.ws}); break;
        case 5: prepconv_phase(p, l, rep); break;
        case 6: mixer_phase(p, l, rep); break;
        case 7: finish_phase(p, l, Mx); break;
        case 8: gemm_phase(Gemm{H, WMOUT, Mx, 1024, 1024}, EpiResid{xo, p.ws, l, 5, 0, l == 0, (const float*)xo}, TX, l == 0 ? 4 : 0); break;
        case 9: norm_phase(p, l, 2, 6, false, Mx, (l == 0 && rep == 0) ? 4 : 0); break;
        case 10: gemm_phase(Gemm{H, WIN + (size_t)5632 * 1024, Mx, 5632, 1024}, EpiSwiglu{ACTw}); break;
        case 11: gemm_phase(Gemm{ACT, WOUT + (size_t)1024 * 2816, Mx, 1024, 2816}, EpiResid{xo, p.ws, l, 8, 1, l == 0, (const float*)xo}, TX, l == 0 ? 8 : 0); break;
      }
      if (rep + 1 < 1 + ((REPMASK >> s) & 1)) GSYNC();
      }
    }
    if (ph + 1 < p.ph_hi) { GSYNC(); for (int q = 0; q < SYNCX; ++q) GSYNC(); }
  }
}

extern "C" void kernel_launch(void* const* d_in, const int* in_sizes, int n_in, void* d_out, int out_size, void* d_ws,
                              size_t ws_size, hipStream_t stream) {
  static int grid = 0;
  if (grid == 0) {
    if (n_in != 29 || ws_size < WS_END) {
      fprintf(stderr, "kernel_launch: need 29 inputs and %zu bytes of ws; got %d, %zu\n", (size_t)WS_END, n_in, ws_size);
      grid = -1; return;
    }
    int dev = 0, cus = 0, per_cu = 0;
    hipGetDevice(&dev);
    hipDeviceGetAttribute(&cus, hipDeviceAttributeMultiprocessorCount, dev);
    if (hipFuncSetAttribute((const void*)mega, hipFuncAttributeMaxDynamicSharedMemorySize, LDS_BYTES) != hipSuccess) {
      fprintf(stderr, "kernel_launch: hipFuncSetAttribute failed\n"); grid = -1; return;
    }
    hipOccupancyMaxActiveBlocksPerMultiprocessor(&per_cu, (const void*)mega, NTHR, LDS_BYTES);
    if (per_cu < 1) { fprintf(stderr, "kernel_launch: occupancy query says %d blocks/CU\n", per_cu); per_cu = 1; }
    (void)hipGetLastError();
    grid = cus;
  }
  if (grid < 0) return;
  P p{};
  const float** pp = (const float**)&p;
  for (int i = 0; i < 29; ++i) pp[i] = (const float*)d_in[i];
  p.out = (float*)d_out;
  p.ws = (unsigned char*)d_ws;
  p.ph_lo = 0; p.ph_hi = NPHASE;
  if (hipMemsetAsync((char*)d_ws + WS_BAR, 0, BAR_BYTES, stream) != hipSuccess) { fprintf(stderr, "kernel_launch: memset failed\n"); return; }
  void* args[] = {&p};
  hipError_t e = hipLaunchCooperativeKernel((const void*)mega, dim3(grid), dim3(NTHR), args, LDS_BYTES, stream);
  if (e != hipSuccess) fprintf(stderr, "cooperative launch failed: %s (grid %d)\n", hipGetErrorString(e), grid);
}
```

```cpp
#include <hip/hip_runtime.h>
#include <hip/hip_bf16.h>
#include <hip/hip_cooperative_groups.h>
#include <cstdio>
namespace cg = cooperative_groups;

typedef unsigned short u16;
using bf16x8 = __attribute__((ext_vector_type(8))) short;
using s16x4 = __attribute__((ext_vector_type(4))) short;
using f32x4 = __attribute__((ext_vector_type(4))) float;
using f32x16 = __attribute__((ext_vector_type(16))) float;
#define DI __device__ __forceinline__

constexpr int D = 1024, TX = 16384, TCX = 2048, T = 18432, DFF = 2816, PINP = 3328;
constexpr int NTHR = 512;
#define MIXPROBE 0
constexpr int LDS_BYTES = 131072 + 256;
constexpr int LDS_CTL = 131072;

constexpr size_t WS_WIN = 0;
constexpr size_t WS_WOUT = WS_WIN + 2ull * 5632 * 1024 * 2;
constexpr size_t WS_MIN = WS_WOUT + 2ull * 1024 * 2816 * 2;
constexpr size_t WS_MOUT = WS_MIN + 3328ull * 1024 * 2;
constexpr size_t WS_XC = WS_MOUT + 1024ull * 1024 * 2;
constexpr size_t WS_MOD = WS_XC + 2048ull * 1024 * 4;
constexpr size_t WS_ROPE = WS_MOD + 2ull * 9 * 9216 * 4;
constexpr size_t WS_MISC = WS_ROPE + 64 * 16 * 2 * 4;
constexpr size_t WS_BAR = WS_MISC + 256;
constexpr size_t BAR_BYTES = 3456 * 4;
constexpr size_t WS_LORA = WS_BAR + 16384;
constexpr size_t WS_H = WS_LORA + 196608ull * 2;
constexpr size_t WS_R1 = WS_H + (size_t)T * 1024 * 2;
constexpr size_t SZ256 = (size_t)T * 256 * 2;
constexpr size_t WS_ACT = WS_R1;
constexpr size_t WS_FR = WS_R1;
constexpr size_t WS_Y = WS_R1;
constexpr size_t WS_SLAB = WS_R1 + 112ull * 1024 * 1024;
constexpr size_t WS_FC = WS_FR + (size_t)T * 1152 * 2;
constexpr size_t WS_Q = WS_FC + (size_t)T * 512 * 2;
constexpr size_t WS_KK = WS_Q + (size_t)T * 512 * 2;
constexpr size_t WS_VT = WS_KK + (size_t)T * 512 * 2;
constexpr size_t WS_SC = WS_VT + (size_t)T * 512 * 2;
constexpr size_t WS_G = WS_SC + 9 * SZ256;
constexpr size_t WS_BON = WS_G + SZ256;
constexpr size_t WS_END = WS_BON + SZ256;

struct P {
  const float *x, *c, *ctx, *c_ctx, *ada_w, *ada_b, *norm_g, *ffn_w_in, *ffn_w_out, *mix_w_in, *mix_w_out,
      *mu, *w0, *w2, *a0, *a2, *g2, *kk, *ka, *rk, *ln_g, *ln_b, *dw_w, *dw_b, *cln_g, *cln_b, *lam, *dng, *final_g;
  float* out;
  unsigned char* ws;
  int ph_lo, ph_hi;
};

extern __shared__ __attribute__((aligned(16))) unsigned char smem[];

DI int otid() { int t = threadIdx.x; asm volatile("" : "+v"(t)); return t; }
DI int obid() { int b = blockIdx.x; asm volatile("" : "+s"(b)); return b; }
DI u16 f2bf(float x) { __bf16 b = (__bf16)x; return __builtin_bit_cast(u16, b); }
DI float bf2f(u16 h) { return __uint_as_float(((unsigned)h) << 16); }
DI unsigned pack2(float a, float b) { return (unsigned)f2bf(a) | ((unsigned)f2bf(b) << 16); }
DI float sigm(float x) { return __builtin_amdgcn_rcpf(1.f + __builtin_amdgcn_exp2f(-1.4426950408889634f * x)); }
DI float wave_sum(float v);
template <int CTRL> DI float dppx(float v) {
  return __int_as_float(__builtin_amdgcn_update_dpp(0, __float_as_int(v), CTRL, 0xF, 0xF, true));
}
DI float allred16(float v) {
  v += dppx<0xB1>(v); v += dppx<0x4E>(v); v += dppx<0x141>(v); v += dppx<0x140>(v);
  return v;
}
DI float wave_sum(float v) {
  v = allred16(v);
  v += __shfl_xor(v, 16);
  v += __shfl_xor(v, 32);
  return v;
}
DI float* xrow(const P& p, int row) {
  return row < TX ? p.out + (size_t)row * D : (float*)(p.ws + WS_XC) + (size_t)(row - TX) * D;
}

DI void tr_tile(const float* W, int N, int K, u16* Wt, int kt, int ntile, int mode) {
  float* tile = (float*)smem;
  const int tid = otid();
  const int k0 = kt * 64, np0 = ntile * 64;
  int n0 = np0; bool valid = true;
  if (mode == 1) { int tl = np0 >> 8, half = (np0 >> 7) & 1, jj = np0 & 127; n0 = half * DFF + tl * 128 + jj; }
  if (mode == 2) { valid = np0 < 3200; }
  {
    const int kr = tid >> 4, nc = (tid & 15) * 4;
#pragma unroll
    for (int pz = 0; pz < 2; ++pz) {
      const int k = kr + 32 * pz;
      float4 v = make_float4(0.f, 0.f, 0.f, 0.f);
      if (valid) v = *(const float4*)&W[(size_t)(k0 + k) * N + n0 + nc];
      tile[k * 65 + nc + 0] = v.x; tile[k * 65 + nc + 1] = v.y; tile[k * 65 + nc + 2] = v.z; tile[k * 65 + nc + 3] = v.w;
    }
  }
  __syncthreads();
  {
    const int np = tid >> 3, ks = (tid & 7) * 8;
    uint4 o;
    o.x = pack2(tile[(ks + 0) * 65 + np], tile[(ks + 1) * 65 + np]);
    o.y = pack2(tile[(ks + 2) * 65 + np], tile[(ks + 3) * 65 + np]);
    o.z = pack2(tile[(ks + 4) * 65 + np], tile[(ks + 5) * 65 + np]);
    o.w = pack2(tile[(ks + 6) * 65 + np], tile[(ks + 7) * 65 + np]);
    *(uint4*)&Wt[(size_t)(np0 + np) * K + k0 + ks] = o;
  }
  __syncthreads();
}

DI void mod_item(const P& p, int idx) {
  float* cond = (float*)smem;
  float* red = cond + 9216;
  const int tid = otid(), lane = tid & 63, w = tid >> 6;
  const int l2 = idx / 144, n0 = (idx % 144) * 64;
  for (int i = tid; i < 9216; i += NTHR) {
    int m = i >> 10, k = i & 1023;
    float v = m < 8 ? p.c[m * 1024 + k] : p.c_ctx[k];
    cond[i] = v * sigm(v);
  }
  __syncthreads();
  float acc[9];
#pragma unroll
  for (int m = 0; m < 9; ++m) acc[m] = 0.f;
  const float* wp = p.ada_w + ((size_t)l2 * 1024 + w * 128) * 9216 + n0 + lane;
#pragma unroll 4
  for (int k = 0; k < 128; ++k) {
    float wv = wp[(size_t)k * 9216];
#pragma unroll
    for (int m = 0; m < 9; ++m) acc[m] += cond[m * 1024 + w * 128 + k] * wv;
  }
#pragma unroll
  for (int m = 0; m < 9; ++m) red[(w * 9 + m) * 64 + lane] = acc[m];
  __syncthreads();
  float* mod = (float*)(p.ws + WS_MOD);
  for (int o = tid; o < 576; o += NTHR) {
    int m = o >> 6, ln = o & 63;
    float s = 0.f;
#pragma unroll
    for (int ww = 0; ww < 8; ++ww) s += red[(ww * 9 + m) * 64 + ln];
    mod[(size_t)(l2 * 9 + m) * 9216 + n0 + ln] = s + p.ada_b[l2 * 9216 + n0 + ln];
  }
  __syncthreads();
}

DI void misc_item(const P& p) {
  const int tid = otid();
  float* rope = (float*)(p.ws + WS_ROPE);
  for (int i = tid; i < 1024; i += NTHR) {
    int pos = i >> 4, f = i & 15;
    float inv = exp2f(-(float)f * (13.287712379549449f / 16.f));
    float ang = (float)pos * inv;
    float kq = rintf(ang * 0.15915494309189535f);
    float r = fmaf(-kq, 6.28125f, ang);
    r = fmaf(-kq, 1.9353071795864769e-3f, r);
    rope[i * 2 + 0] = cosf(r);
    rope[i * 2 + 1] = sinf(r);
  }
  if (tid < 2) {
    const float* lv = p.lam + tid * 256;
    float s1 = 0.f, s2 = 0.f;
    for (int i = 0; i < 64; ++i) { s1 += lv[i] * lv[64 + i]; s2 += lv[128 + i] * lv[192 + i]; }
    float li = 0.8f - 0.6f * expf(-0.3f * (float)tid);
    float* mf = (float*)(p.ws + WS_MISC);
    mf[tid] = expf(s1) - expf(s2) + li;
    mf[2 + tid] = li;
  }
  if (tid >= 8 && tid < 16) ((unsigned*)(p.ws + WS_MISC))[tid] = 0u;
}

DI void lora_item(const P& p, int i) {
  u16* LW = (u16*)(p.ws + WS_LORA);
  const int tid = otid();
#pragma unroll
  for (int q = 0; q < 4; ++q) {
    const int e = i * 2048 + q * NTHR + tid;
    float v;
    if (e < 131072) {
      const int e1 = e & 65535, r = e1 & 63, c = (e1 >> 6) & 255, ld = e1 >> 14;
      const float* src = e < 65536 ? p.w2 : p.a2;
      v = src[((size_t)ld * 64 + r) * 256 + c];
    } else {
      const int e1 = e - 131072, r = e1 & 127, c = (e1 >> 7) & 255, l_ = e1 >> 15;
      v = p.g2[((size_t)l_ * 128 + r) * 256 + c];
    }
    LW[e] = f2bf(v);
  }
}

DI void prep_phase(const P& p, int l) {
  const int nconv = 2816 + 1408 + 832 + 256;
  const int total = nconv + (l == 0 ? 289 + 96 : 0);
  for (int it = obid(); it < total; it += gridDim.x) {
    if (it < 2816) {
      int s = it / 1408, r = it % 1408;
      tr_tile(p.ffn_w_in + (size_t)(l * 2 + s) * 1024 * 5632, 5632, 1024, (u16*)(p.ws + WS_WIN) + (size_t)s * 5632 * 1024, r / 88, r % 88, 1);
    } else if (it < 2816 + 1408) {
      int q = it - 2816; int s = q / 704, r = q % 704;
      tr_tile(p.ffn_w_out + (size_t)(l * 2 + s) * 2816 * 1024, 1024, 2816, (u16*)(p.ws + WS_WOUT) + (size_t)s * 1024 * 2816, r / 16, r % 16, 0);
    } else if (it < 2816 + 1408 + 832) {
      int r = it - 4224;
      tr_tile(p.mix_w_in + (size_t)l * 1024 * 3200, 3200, 1024, (u16*)(p.ws + WS_MIN), r / 52, r % 52, 2);
    } else if (it < nconv) {
      int r = it - 5056;
      tr_tile(p.mix_w_out + (size_t)l * 1024 * 1024, 1024, 1024, (u16*)(p.ws + WS_MOUT), r / 16, r % 16, 0);
    } else if (it < nconv + 288) {
      mod_item(p, it - nconv);
    } else if (it == nconv + 288) {
      misc_item(p);
    } else {
      lora_item(p, it - nconv - 289);
    }
  }
}

DI void norm_phase(const P& p, int l, int gi, int si, bool first, int rows, int nslab = 0, bool ctxin = false) {
  const int lane = otid() & 63, w = otid() >> 6;
  const float* modb = (const float*)(p.ws + WS_MOD);
  u16* H = (u16*)(p.ws + WS_H);
  const float* g = p.norm_g + (size_t)(l * 3 + gi) * 1024;
  const int nw = (int)gridDim.x * 8, wid = obid() * 8 + w;
  const int per = nw >> 3;
  const bool grouped = (nw & 7) == 0 && per > 0 && (2048 % per) == 0;
  const int grp = grouped ? wid / per : 0, sub = grouped ? wid - grp * per : 0;
  const int nx = grouped ? 2048 / per : 0;
  const int nsteps = grouped ? nx + ((rows > TX) ? (TCX + nw - 1) / nw : 0) : (rows + nw - 1) / nw;
  int cur_m = -1;
  f32x4 A[4], B[4];
  for (int st = 0; st < nsteps; ++st) {
    int row;
    if (!grouped) { row = st * nw + wid; if (row >= rows) break; }
    else if (st < nx) row = grp * 2048 + st * per + sub;
    else { row = TX + (st - nx) * nw + wid; if (row >= rows) break; }
    const int mrow = row < TX ? (row >> 11) : 8;
    if (mrow != cur_m) {
      const float* md = modb + (size_t)(l * 9 + mrow) * 9216;
#pragma unroll
      for (int c = 0; c < 4; ++c) {
        const int k = (c >> 1) * 512 + lane * 8 + (c & 1) * 4;
        const f32x4 g4 = *(const f32x4*)&g[k], sh = *(const f32x4*)&md[si * 1024 + k], sc = *(const f32x4*)&md[(si + 1) * 1024 + k];
        A[c] = g4 * (sc + 1.f); B[c] = sh;
      }
      cur_m = mrow;
    }
    const bool fin = first || (ctxin && row >= TX);
    const float* src = fin ? (row < TX ? p.x + (size_t)row * D : p.ctx + (size_t)(row - TX) * D) : xrow(p, row);
    f32x4 v[4];
    const bool addsl = nslab > 0 && row >= TX;
#pragma unroll
    for (int c = 0; c < 4; ++c) v[c] = *(const f32x4*)&src[(c >> 1) * 512 + lane * 8 + (c & 1) * 4];
    if (addsl) {
      const u16* sl = (const u16*)(p.ws + WS_SLAB) + (size_t)(row - TX) * D;
      for (int q = 0; q < nslab; ++q) {
#pragma unroll
        for (int c2 = 0; c2 < 2; ++c2) {
          const uint4 a = *(const uint4*)&sl[(size_t)q * TCX * D + c2 * 512 + lane * 8];
          v[2 * c2] += (f32x4){__uint_as_float(a.x << 16), __uint_as_float(a.x & 0xffff0000u), __uint_as_float(a.y << 16), __uint_as_float(a.y & 0xffff0000u)};
          v[2 * c2 + 1] += (f32x4){__uint_as_float(a.z << 16), __uint_as_float(a.z & 0xffff0000u), __uint_as_float(a.w << 16), __uint_as_float(a.w & 0xffff0000u)};
        }
      }
    }
    float ss = 0.f;
#pragma unroll
    for (int c = 0; c < 4; ++c) ss += v[c][0] * v[c][0] + v[c][1] * v[c][1] + v[c][2] * v[c][2] + v[c][3] * v[c][3];
    ss = wave_sum(ss);
    const float rstd = rsqrtf(ss * (1.f / 1024.f) + 1e-6f);
    float* xd = xrow(p, row);
#pragma unroll
    for (int c2 = 0; c2 < 2; ++c2) {
      const f32x4 ha = v[2 * c2] * rstd * A[2 * c2] + B[2 * c2], hb = v[2 * c2 + 1] * rstd * A[2 * c2 + 1] + B[2 * c2 + 1];
      *(uint4*)&H[(size_t)row * 1024 + c2 * 512 + lane * 8] = make_uint4(pack2(ha[0], ha[1]), pack2(ha[2], ha[3]), pack2(hb[0], hb[1]), pack2(hb[2], hb[3]));
      if (addsl) { *(f32x4*)&xd[c2 * 512 + lane * 8] = v[2 * c2]; *(f32x4*)&xd[c2 * 512 + lane * 8 + 4] = v[2 * c2 + 1]; }
    }
  }
}

DI void final_phase(const P& p) {
  const int lane = otid() & 63, w = otid() >> 6;
  float4 gq[4];
#pragma unroll
  for (int c = 0; c < 4; ++c) gq[c] = ((const float4*)p.final_g)[c * 64 + lane];
  for (int row = obid() * 8 + w; row < TX; row += gridDim.x * 8) {
    float* src = p.out + (size_t)row * D;
    float4 v[4];
    float ss = 0.f;
#pragma unroll
    for (int c = 0; c < 4; ++c) {
      v[c] = ((const float4*)src)[c * 64 + lane];
      ss += v[c].x * v[c].x + v[c].y * v[c].y + v[c].z * v[c].z + v[c].w * v[c].w;
    }
    ss = wave_sum(ss);
    const float rstd = rsqrtf(ss * (1.f / 1024.f) + 1e-6f);
#pragma unroll
    for (int c = 0; c < 4; ++c) {
      const float4 g4 = gq[c];
      float4 o = make_float4(v[c].x * rstd * g4.x, v[c].y * rstd * g4.y, v[c].z * rstd * g4.z, v[c].w * rstd * g4.w);
      ((float4*)src)[c * 64 + lane] = o;
    }
  }
}

#define LAS __attribute__((address_space(3)))
constexpr int BM = 256, BK = 64, HALF = 128, HTB = HALF * BK * 2;
DI int lds_byte(int r, int c) { const int st = (r >> 4) * 2 + (c >> 5), rr = r & 15, cc = c & 31, ob = rr * 64 + cc * 2; return st * 1024 + (ob ^ (((ob >> 9) & 1) << 5)); }
DI void stage_rc(int b, int& R, int& C) { const int st = b / 1024, sb = b % 1024, swz = sb ^ (((sb >> 9) & 1) << 5); R = (st >> 1) * 16 + swz / 64; C = (st & 1) * 32 + (swz % 64) / 2; }
DI int perm32(int rho) { const int n = rho >> 4, i = rho & 15; return 8 * (i >> 2) + 4 * n + (i & 3); }
struct Unit { int pm, pn, k0, nkt, q; };
struct Gemm { const u16* A; const u16* Bt; int M, N, K; };
struct StaticOrder {
  int nM, nN, nwg, G, c, nkt, S, ntail;
  DI void init(int M, int N, int K, int G_, int c_, int Mx, int S_) {
    nN = N / BM; G = G_; c = c_; nkt = K / BK; S = S_;
    nM = (S_ > 0 ? Mx : M) / BM; nwg = nM * nN;
    ntail = S_ > 0 ? ((M - Mx) / BM) * nN * S_ : 0;
  }
  DI bool next(int i, Unit& u) const {
    const long L = (long)i * G + c;
    if (L >= nwg + ntail) return false;
    if (L >= nwg) {
      const int r = (int)L - nwg, tt = r / S, q = r - tt * S, nkp = nkt >> 1;
      const int kp0 = (q * nkp) / S, kp1 = ((q + 1) * nkp) / S;
      u.pm = nM + tt / nN; u.pn = tt % nN; u.k0 = 2 * kp0; u.nkt = 2 * (kp1 - kp0); u.q = q;
      return true;
    }
    int wgid = (int)L; { const int q = nwg / 8, r = nwg % 8, xcd = wgid % 8, off = wgid / 8; wgid = (xcd < r ? xcd * (q + 1) : r * (q + 1) + (xcd - r) * q) + off; }
    const int nig = 8 * nN, gid = wgid / nig, fm = gid * 8, gsz = (nM - fm) < 8 ? (nM - fm) : 8;
    u.pm = fm + ((wgid % nig) % gsz); u.pn = (wgid % nig) / gsz; u.k0 = 0; u.nkt = nkt; u.q = 0; return true;
  }
};

struct EpiSwiglu {
  static constexpr bool PERM = true;
  u16* ACT;
  DI void operator()(const f32x4 (&acc)[2][2][4][2], const Unit& u, int wr, int wc, int fr, int fq) const {
    const int row0 = u.pm * BM + wr * 64 + fr, col0 = u.pn * 128 + wc * 32 + 8 * fq;
#pragma unroll
    for (int ai = 0; ai < 2; ++ai)
#pragma unroll
      for (int m = 0; m < 4; ++m) {
        const int row = row0 + ai * HALF + m * 16;
        float v[8];
#pragma unroll
        for (int n = 0; n < 2; ++n)
#pragma unroll
          for (int e = 0; e < 4; ++e) { const float gt = acc[ai][0][m][n][e], up = acc[ai][1][m][n][e]; v[n * 4 + e] = gt * sigm(gt) * up; }
        uint4 o; o.x = pack2(v[0], v[1]); o.y = pack2(v[2], v[3]); o.z = pack2(v[4], v[5]); o.w = pack2(v[6], v[7]);
        *(uint4*)&ACT[(size_t)row * DFF + col0] = o;
      }
  }
};
struct EpiResid {
  static constexpr bool PERM = false;
  float* out; unsigned char* ws; int l, gidx, half, tail; const float* xin;
  DI void operator()(const f32x4 (&acc)[2][2][4][2], const Unit& u, int wr, int wc, int fr, int fq) const {
    float* xc = (float*)(ws + WS_XC); const float* mod = (const float*)(ws + WS_MOD); float* slab = (float*)(ws + WS_SLAB);
    const float sc = half ? 0.5f : 1.f;
    const int brow = u.pm * BM;
    const int mrow = brow < TX ? (brow >> 11) : 8;
    const int col0 = u.pn * BM + wc * 32 + 4 * fq;
    const float* gate = mod + (size_t)(l * 9 + mrow) * 9216 + gidx * 1024 + col0;
    f32x4 gv[2][2];
#pragma unroll
    for (int bj = 0; bj < 2; ++bj)
#pragma unroll
      for (int n = 0; n < 2; ++n) gv[bj][n] = *(const f32x4*)(gate + bj * HALF + n * 16) * sc;
    if (tail && brow >= TX) {
      u16* sp0 = (u16*)slab + ((size_t)u.q * TCX + (size_t)(brow - TX + wr * 64 + fr)) * D + col0;
#pragma unroll
      for (int ai = 0; ai < 2; ++ai)
#pragma unroll
        for (int m = 0; m < 4; ++m)
#pragma unroll
          for (int bj = 0; bj < 2; ++bj)
#pragma unroll
            for (int n = 0; n < 2; ++n) {
              const f32x4 d = gv[bj][n] * acc[ai][bj][m][n];
              *(uint2*)(sp0 + (size_t)(ai * HALF + m * 16) * D + bj * HALF + n * 16) = make_uint2(pack2(d[0], d[1]), pack2(d[2], d[3]));
            }
      return;
    }
#pragma unroll
    for (int ai = 0; ai < 2; ++ai) {
      f32x4 xv[4][2][2];
      float* xp0 = (brow < TX ? out + (size_t)(brow + ai * HALF + wr * 64 + fr) * D : xc + (size_t)(brow - TX + ai * HALF + wr * 64 + fr) * D) + col0;
      const float* rp0 = (brow < TX ? xin + (size_t)(brow + ai * HALF + wr * 64 + fr) * D : xc + (size_t)(brow - TX + ai * HALF + wr * 64 + fr) * D) + col0;
#pragma unroll
      for (int m = 0; m < 4; ++m)
#pragma unroll
        for (int bj = 0; bj < 2; ++bj)
#pragma unroll
          for (int n = 0; n < 2; ++n) xv[m][bj][n] = *(const f32x4*)(rp0 + (size_t)m * 16 * D + bj * HALF + n * 16);
#pragma unroll
      for (int m = 0; m < 4; ++m)
#pragma unroll
        for (int bj = 0; bj < 2; ++bj)
#pragma unroll
          for (int n = 0; n < 2; ++n) *(f32x4*)(xp0 + (size_t)m * 16 * D + bj * HALF + n * 16) = xv[m][bj][n] + gv[bj][n] * acc[ai][bj][m][n];
    }
  }
};
struct EpiMix {
  static constexpr bool PERM = false;
  unsigned char* ws;
  DI void operator()(const f32x4 (&acc)[2][2][4][2], const Unit& u, int wr, int wc, int fr, int fq) const {
    const float* rope = (const float*)(ws + WS_ROPE);
    const int brow = u.pm * BM, bcol = u.pn * BM;
    const bool isx = brow < TX;
    const int bb = isx ? (brow >> 11) : ((brow - TX) >> 8);
#pragma unroll
    for (int bj = 0; bj < 2; ++bj) {
      const int base32 = bcol + bj * HALF + wc * 32;
      if (base32 >= 3200) continue;
      if (base32 < 1664) {
        u16* dst; int ld, cb;
        if (base32 < 1152) { dst = (u16*)(ws + WS_FR); ld = 1152; cb = base32; }
        else { dst = (u16*)(ws + WS_FC); ld = 512; cb = base32 - 1152; }
#pragma unroll
        for (int ai = 0; ai < 2; ++ai)
#pragma unroll
          for (int m = 0; m < 4; ++m) {
            const int row = brow + ai * HALF + wr * 64 + m * 16 + fr;
            const uint2 q0 = make_uint2(pack2(acc[ai][bj][m][0][0], acc[ai][bj][m][0][1]), pack2(acc[ai][bj][m][0][2], acc[ai][bj][m][0][3]));
            const uint2 q1 = make_uint2(pack2(acc[ai][bj][m][1][0], acc[ai][bj][m][1][1]), pack2(acc[ai][bj][m][1][2], acc[ai][bj][m][1][3]));
            const bool od = fq & 1;
            const uint2 snd = od ? q0 : q1;
            const uint2 rcv = make_uint2((unsigned)__shfl_xor((int)snd.x, 16), (unsigned)__shfl_xor((int)snd.y, 16));
            const uint4 o4 = od ? make_uint4(rcv.x, rcv.y, q1.x, q1.y) : make_uint4(q0.x, q0.y, rcv.x, rcv.y);
            *(uint4*)&dst[(size_t)row * ld + cb + (od ? 16 + 4 * (fq - 1) : 4 * fq)] = o4;
          }
      } else if (base32 < 2688) {
        const bool isq = base32 < 2176;
        const int cb = isq ? base32 - 1664 : base32 - 2176;
        const int axis = (base32 >> 5) & 1;
        const float qs = isq ? 0.125f * 1.4426950408889634f : 1.f;
#pragma unroll
        for (int ai = 0; ai < 2; ++ai)
#pragma unroll
          for (int m = 0; m < 4; ++m) {
            const int row = brow + ai * HALF + wr * 64 + m * 16 + fr;
            f32x4 t1 = acc[ai][bj][m][0], t2 = acc[ai][bj][m][1];
            int keyidx;
            if (isx) {
              const int npos = row & 2047;
              const int ps = axis ? (npos & 63) : (npos >> 6);
              const f32x4 ca = *(const f32x4*)&rope[(ps * 16 + 4 * fq) * 2];
              const f32x4 cb4 = *(const f32x4*)&rope[(ps * 16 + 4 * fq) * 2 + 4];
              const f32x4 cs = {ca[0], ca[2], cb4[0], cb4[2]}, sn = {ca[1], ca[3], cb4[1], cb4[3]};
              const f32x4 o1 = t1 * cs - t2 * sn, o2 = t2 * cs + t1 * sn;
              t1 = o1; t2 = o2; keyidx = npos;
            } else keyidx = 2048 + ((row - TX) & 255);
            t1 = t1 * qs; t2 = t2 * qs;
            const uint2 q0 = make_uint2(pack2(t1[0], t1[1]), pack2(t1[2], t1[3]));
            const uint2 q1 = make_uint2(pack2(t2[0], t2[1]), pack2(t2[2], t2[3]));
            const bool od = fq & 1;
            const uint2 snd = od ? q0 : q1;
            const uint2 rcv = make_uint2((unsigned)__shfl_xor((int)snd.x, 16), (unsigned)__shfl_xor((int)snd.y, 16));
            const uint4 o4 = od ? make_uint4(rcv.x, rcv.y, q1.x, q1.y) : make_uint4(q0.x, q0.y, rcv.x, rcv.y);
            u16* dst = isq ? (u16*)(ws + WS_Q) + (size_t)row * 512 + cb
                           : (u16*)(ws + WS_KK) + ((size_t)bb * 2304 + keyidx) * 512 + cb;
            *(uint4*)(dst + (od ? 16 + 4 * (fq - 1) : 4 * fq)) = o4;
          }
      } else {
        u16* VT = (u16*)(ws + WS_VT);
        const int cb = base32 - 2688;
#pragma unroll
        for (int ai = 0; ai < 2; ++ai)
#pragma unroll
          for (int m = 0; m < 4; ++m) {
            const int rowb = brow + ai * HALF + wr * 64 + m * 16 + (fr & ~3);
            const int keyb = isx ? (rowb & 2047) : 2048 + ((rowb - TX) & 255);
            const bool od1 = fr & 1, od2 = (fr >> 1) & 1;
            unsigned own[8];
#pragma unroll
            for (int n = 0; n < 2; ++n)
#pragma unroll
              for (int e = 0; e < 4; ++e) own[n * 4 + e] = (unsigned)f2bf(acc[ai][bj][m][n][e]);
            unsigned pr[4];
#pragma unroll
            for (int i = 0; i < 4; ++i) {
              const unsigned snd = od1 ? own[i] : own[4 + i], kp = od1 ? own[4 + i] : own[i];
              const unsigned rc = (unsigned)__builtin_amdgcn_update_dpp(0, (int)snd, 0xB1, 0xF, 0xF, true);
              pr[i] = od1 ? (rc | (kp << 16)) : (kp | (rc << 16));
            }
#pragma unroll
            for (int j = 0; j < 2; ++j) {
              const unsigned snd = od2 ? pr[j] : pr[2 + j], kp = od2 ? pr[2 + j] : pr[j];
              const unsigned rc = (unsigned)__builtin_amdgcn_update_dpp(0, (int)snd, 0x4E, 0xF, 0xF, true);
              const uint2 o2 = od2 ? make_uint2(rc, kp) : make_uint2(kp, rc);
              const int cc = cb + (od1 ? 16 : 0) + 4 * fq + (od2 ? 2 : 0) + j;
              *(uint2*)&VT[((size_t)bb * 512 + cc) * 2304 + keyb] = o2;
            }
          }
      }
    }
  }
};

template <class Epi>
DI void gemm_phase(const Gemm g, const Epi& E, int Mx = 0, int S_ = 0) {
  LAS unsigned char* lds = (LAS unsigned char*)smem;
  StaticOrder S; S.init(g.M, g.N, g.K, (int)gridDim.x, (int)obid(), Mx, S_);
  const int tid = otid(), wid = __builtin_amdgcn_readfirstlane(tid >> 6), lane = tid & 63, wr = wid >> 2, wc = wid & 3, fr = lane & 15, fq = lane >> 4;
  const int K = g.K;
  unsigned voffA[2], voffB[2];
#pragma unroll
  for (int i = 0; i < 2; ++i) { int R, C; stage_rc(tid * 16 + i * 8192, R, C); const int Rb = Epi::PERM ? ((R & ~31) + perm32(R & 31)) : R;
    voffA[i] = (unsigned)(R * K + C) * 2u; voffB[i] = (unsigned)(Rb * K + C) * 2u; }
  const size_t kstep = (size_t)(BK * 2);
  const size_t hstep = (size_t)HALF * K * 2;
  const size_t tstep = 2 * hstep;
  const unsigned ldsw = (unsigned)wid * 1024u;
  const int aoff = lds_byte(wr * 64 + fr, fq * 8), boff = lds_byte(wc * 32 + fr, fq * 8);
#define PG8_SA(b, h) (((b) * 2 + (h)) * HTB)
#define PG8_SB(b, h) ((4 + (b) * 2 + (h)) * HTB)
#define PG8_STAGE(bufoff, gbase, voff) do { _Pragma("unroll") for (int _i = 0; _i < 2; ++_i) \
    __builtin_amdgcn_global_load_lds((const unsigned*)((const char*)(gbase) + (voff)[_i]), (LAS unsigned*)(lds + (bufoff) + ldsw + _i * 8192), 16, 0, 0); } while (0)
#define PG8_LDA(dst, b, h) do { _Pragma("unroll") for (int m = 0; m < 4; ++m) _Pragma("unroll") for (int k = 0; k < 2; ++k) dst[m][k] = *(const LAS bf16x8*)(lds + PG8_SA(b, h) + aoff + m * 2048 + k * 1024); } while (0)
#define PG8_LDB(dst, b, h) do { _Pragma("unroll") for (int n = 0; n < 2; ++n) _Pragma("unroll") for (int k = 0; k < 2; ++k) dst[n][k] = *(const LAS bf16x8*)(lds + PG8_SB(b, h) + boff + n * 2048 + k * 1024); } while (0)
#define PG8_MMA(ai, bj, At, Bt) do { __builtin_amdgcn_s_setprio(1); _Pragma("unroll") for (int m = 0; m < 4; ++m) _Pragma("unroll") for (int n = 0; n < 2; ++n) _Pragma("unroll") for (int k = 0; k < 2; ++k) \
    acc[ai][bj][m][n] = __builtin_amdgcn_mfma_f32_16x16x32_bf16(Bt[n][k], At[m][k], acc[ai][bj][m][n], 0, 0, 0); __builtin_amdgcn_s_setprio(0); } while (0)
#define PG8_WAIT_V(n) asm volatile("s_waitcnt vmcnt(" #n ")" ::: "memory")
#define PG8_WAIT_L(n) asm volatile("s_waitcnt lgkmcnt(" #n ")" ::: "memory")
#define PG8_BAR __builtin_amdgcn_s_barrier()
#define PG8_SCHED __builtin_amdgcn_sched_barrier(0)
  Unit cur, nxt; int ui = 0;
  if (!S.next(0, cur)) return;
  f32x4 acc[2][2][4][2];
#pragma unroll
  for (int a = 0; a < 2; ++a)
#pragma unroll
    for (int b = 0; b < 2; ++b)
#pragma unroll
      for (int m = 0; m < 4; ++m)
#pragma unroll
        for (int n = 0; n < 2; ++n) acc[a][b][m][n] = (f32x4){0.f, 0.f, 0.f, 0.f};
  bf16x8 At[4][2], B0[2][2], B1[2][2];
  const char* cA = (const char*)g.A + (size_t)cur.pm * tstep + (size_t)cur.k0 * kstep; const char* cB = (const char*)g.Bt + (size_t)cur.pn * tstep + (size_t)cur.k0 * kstep;
  PG8_STAGE(PG8_SB(0, 0), cB, voffB); PG8_STAGE(PG8_SA(0, 0), cA, voffA); PG8_STAGE(PG8_SB(0, 1), cB + hstep, voffB); PG8_STAGE(PG8_SA(0, 1), cA + hstep, voffA);
  if (wr == 1) PG8_BAR;
  PG8_WAIT_V(4); PG8_BAR;
  PG8_STAGE(PG8_SB(1, 0), cB + kstep, voffB); PG8_STAGE(PG8_SA(1, 0), cA + kstep, voffA); PG8_STAGE(PG8_SB(1, 1), cB + hstep + kstep, voffB);
  PG8_WAIT_V(6); PG8_BAR;
  for (;;) {
    const bool has_next = S.next(ui + 1, nxt);
    const char* nA = has_next ? (const char*)g.A + (size_t)nxt.pm * tstep + (size_t)nxt.k0 * kstep : cA; const char* nB = has_next ? (const char*)g.Bt + (size_t)nxt.pn * tstep + (size_t)nxt.k0 * kstep : cB;
    const int nt = cur.nkt;
    for (int t = 0; t < nt; t += 2) {
      const bool last = (t == nt - 2);
      const char* a1 = cA + (size_t)(t + 1) * kstep;
      const char* a2 = last ? nA : cA + (size_t)(t + 2) * kstep; const char* b2 = last ? nB : cB + (size_t)(t + 2) * kstep;
      const char* a3 = a2 + kstep; const char* b3 = b2 + kstep;
      PG8_LDB(B0, 0, 0); PG8_SCHED; PG8_LDA(At, 0, 0); PG8_STAGE(PG8_SA(1, 1), a1 + hstep, voffA);
      PG8_WAIT_L(8); PG8_BAR; PG8_WAIT_L(0); PG8_MMA(0, 0, At, B0); PG8_BAR; PG8_SCHED;
      PG8_LDB(B1, 0, 1); PG8_STAGE(PG8_SB(0, 0), b2, voffB);
      PG8_BAR; PG8_WAIT_L(0); PG8_MMA(0, 1, At, B1); PG8_BAR;
      PG8_LDA(At, 0, 1); PG8_STAGE(PG8_SA(0, 0), a2, voffA);
      PG8_BAR; PG8_WAIT_L(0); PG8_MMA(1, 0, At, B0); PG8_BAR; PG8_SCHED;
      PG8_STAGE(PG8_SB(0, 1), b2 + hstep, voffB);
      PG8_WAIT_V(6); PG8_BAR; PG8_MMA(1, 1, At, B1); PG8_BAR;
      PG8_LDB(B0, 1, 0); PG8_SCHED; PG8_LDA(At, 1, 0); PG8_STAGE(PG8_SA(0, 1), a2 + hstep, voffA);
      PG8_WAIT_L(8); PG8_BAR; PG8_WAIT_L(0); PG8_MMA(0, 0, At, B0); PG8_BAR; PG8_SCHED;
      PG8_LDB(B1, 1, 1); PG8_STAGE(PG8_SB(1, 0), b3, voffB);
      PG8_BAR; PG8_WAIT_L(0); PG8_MMA(0, 1, At, B1); PG8_BAR;
      PG8_LDA(At, 1, 1); PG8_STAGE(PG8_SA(1, 0), a3, voffA);
      PG8_BAR; PG8_WAIT_L(0); PG8_MMA(1, 0, At, B0); PG8_BAR; PG8_SCHED;
      PG8_STAGE(PG8_SB(1, 1), b3 + hstep, voffB);
      PG8_WAIT_V(6); PG8_BAR; PG8_MMA(1, 1, At, B1); PG8_BAR;
    }
    E(acc, cur, wr, wc, fr, fq);
    if (!has_next) break;
#pragma unroll
    for (int a = 0; a < 2; ++a)
#pragma unroll
      for (int b = 0; b < 2; ++b)
#pragma unroll
        for (int m = 0; m < 4; ++m)
#pragma unroll
          for (int n = 0; n < 2; ++n) acc[a][b][m][n] = (f32x4){0.f, 0.f, 0.f, 0.f};
    cur = nxt; cA = nA; cB = nB; ++ui;
  }
  PG8_WAIT_V(0);
  if (wr == 0) PG8_BAR;
  PG8_BAR;
#undef PG8_SA
#undef PG8_SB
#undef PG8_STAGE
#undef PG8_LDA
#undef PG8_LDB
#undef PG8_MMA
}


constexpr int FS_LD = 772;
constexpr int AB_LD = 392;
constexpr int PRM_OFF = 32 * FS_LD * 4 + 32 * AB_LD * 2;
DI float blo(unsigned u) { return __uint_as_float(u << 16); }
DI float bhi(unsigned u) { return __uint_as_float(u & 0xffff0000u); }
DI void rwkv_prep_item(const P& p, int l, int item) {
  float* fs = (float*)smem;
  u16* ab = (u16*)(smem + 32 * FS_LD * 4);
  const int tid = otid();
  const int t0 = item * 32;
  int L, n0;
  if (t0 < TX) { L = 2048; n0 = t0 & 2047; } else { L = 256; n0 = (t0 - TX) & 255; }
  const u16* FR = (const u16*)(p.ws + WS_FR);
  const float* mu0 = p.mu + (size_t)l * 2 * 1152;
  const float* mu1 = mu0 + 1152;
  {
    uint4 fu[9], pu[9], nu[9];
#pragma unroll
    for (int q = 0; q < 9; ++q) {
      const int idx = q * NTHR + tid;
      const int tk = idx / 144, ci = (idx - tk * 144) * 8;
      const int n = n0 + tk;
      const size_t row = (size_t)(t0 + tk);
      fu[q] = *(const uint4*)&FR[row * 1152 + ci];
      pu[q] = *(const uint4*)&FR[(row - (n > 0 ? 1 : 0)) * 1152 + ci];
      nu[q] = *(const uint4*)&FR[(row + (n < L - 1 ? 1 : 0)) * 1152 + ci];
    }
#pragma unroll
    for (int q = 0; q < 9; ++q) {
      const int idx = q * NTHR + tid;
      const int tk = idx / 144, ci = (idx - tk * 144) * 8;
      const int n = n0 + tk;
      const uint4 z4 = make_uint4(0u, 0u, 0u, 0u);
      const uint4 pq = n > 0 ? pu[q] : z4, nq = n < L - 1 ? nu[q] : z4;
      const unsigned fw[4] = {fu[q].x, fu[q].y, fu[q].z, fu[q].w}, pw_[4] = {pq.x, pq.y, pq.z, pq.w}, nw_[4] = {nq.x, nq.y, nq.z, nq.w};
      f32x4 v[2];
#pragma unroll
      for (int hlf = 0; hlf < 2; ++hlf) {
        const f32x4 m0 = *(const f32x4*)&mu0[ci + 4 * hlf], m1 = *(const f32x4*)&mu1[ci + 4 * hlf];
        const f32x4 ff = {blo(fw[2 * hlf]), bhi(fw[2 * hlf]), blo(fw[2 * hlf + 1]), bhi(fw[2 * hlf + 1])};
        const f32x4 pp = {blo(pw_[2 * hlf]), bhi(pw_[2 * hlf]), blo(pw_[2 * hlf + 1]), bhi(pw_[2 * hlf + 1])};
        const f32x4 nn = {blo(nw_[2 * hlf]), bhi(nw_[2 * hlf]), blo(nw_[2 * hlf + 1]), bhi(nw_[2 * hlf + 1])};
        v[hlf] = ff + m0 * (pp - ff) + m1 * (nn - ff);
      }
      if (ci < 768) { *(f32x4*)&fs[tk * FS_LD + ci] = v[0]; *(f32x4*)&fs[tk * FS_LD + ci + 4] = v[1]; }
      else {
        const bool isT = ci < 896, isS = ci >= 1024;
        const float sc = isT ? 2.f : 1.f;
#pragma unroll
        for (int hlf = 0; hlf < 2; ++hlf)
#pragma unroll
          for (int e = 0; e < 4; ++e) { const float y = sigm(sc * v[hlf][e]); v[hlf][e] = isT ? 2.f * y - 1.f : (isS ? y : v[hlf][e]); }
        *(uint4*)&ab[tk * AB_LD + (ci - 768)] = make_uint4(pack2(v[0][0], v[0][1]), pack2(v[0][2], v[0][3]), pack2(v[1][0], v[1][1]), pack2(v[1][2], v[1][3]));
      }
    }
  }
  __syncthreads();
  const int lane = tid & 63, w = tid >> 6, h = w & 3, mt = w >> 2, col = lane & 15, kc = lane >> 4;
  bf16x8 af_[12];
#pragma unroll
  for (int i = 0; i < 12; ++i) af_[i] = *(const bf16x8*)&ab[(mt * 16 + col) * AB_LD + i * 32 + kc * 8];
  const u16* LW = (const u16*)(p.ws + WS_LORA);
  const u16* W2T = LW + (size_t)(l * 2) * 256 * 64;
  const u16* A2T = LW + 65536 + (size_t)(l * 2) * 256 * 64;
  const u16* G2T = LW + 131072 + (size_t)l * 256 * 128;
  const int tk = mt * 16 + col;
  const float* fr_ = fs + tk * FS_LD;
  float rsq = 0.f;
#pragma unroll
  for (int nt = 0; nt < 4; ++nt) {
    const int c4 = h * 64 + nt * 16 + kc * 4;
    const float4 kv = *(const float4*)&fr_[256 + c4];
    const float4 ks4 = *(const float4*)&((const float*)(smem + PRM_OFF))[4 * 256 + c4];
    const float q0 = kv.x * ks4.x, q1 = kv.y * ks4.y, q2 = kv.z * ks4.z, q3 = kv.w * ks4.w;
    rsq += q0 * q0 + q1 * q1 + q2 * q2 + q3 * q3;
  }
  rsq += __shfl_xor(rsq, 16); rsq += __shfl_xor(rsq, 32);
  const float rs = rsqrtf(rsq + 1e-12f);
  float bsp = 0.f;
  u16* SC = (u16*)(p.ws + WS_SC);
  u16* Gp = (u16*)(p.ws + WS_G);
  u16* BON = (u16*)(p.ws + WS_BON);
  constexpr size_t AS = (size_t)T * 256;
  bf16x8 wq[2][12];
#define LOADW(buf, nt_) do { const int ca_ = h * 64 + ((nt_) >> 1) * 32 + (col >> 2) * 8 + ((nt_) & 1) * 4 + (col & 3);     \
    _Pragma("unroll") for (int ks = 0; ks < 2; ++ks) { \
      wq[buf][0 + ks] = *(const bf16x8*)&W2T[(size_t)ca_ * 64 + ks * 32 + kc * 8]; \
      wq[buf][2 + ks] = *(const bf16x8*)&W2T[(size_t)(256 + ca_) * 64 + ks * 32 + kc * 8]; \
      wq[buf][4 + ks] = *(const bf16x8*)&A2T[(size_t)ca_ * 64 + ks * 32 + kc * 8]; \
      wq[buf][6 + ks] = *(const bf16x8*)&A2T[(size_t)(256 + ca_) * 64 + ks * 32 + kc * 8]; } \
    _Pragma("unroll") for (int ks = 0; ks < 4; ++ks) wq[buf][8 + ks] = *(const bf16x8*)&G2T[(size_t)ca_ * 128 + ks * 32 + kc * 8]; } while (0)
  uint2 lo_[10];
  LOADW(0, 0);
#pragma unroll
  for (int nt = 0; nt < 4; ++nt) {
    if (nt + 1 < 4) LOADW((nt + 1) & 1, nt + 1);
    const int c4 = h * 64 + (nt >> 1) * 32 + kc * 8 + (nt & 1) * 4;
    f32x4 cwf = {0.f, 0.f, 0.f, 0.f}, cwb = cwf, caf = cwf, cab = cwf, cg = cwf;
#pragma unroll
    for (int ks = 0; ks < 2; ++ks) {
      cwf = __builtin_amdgcn_mfma_f32_16x16x32_bf16(wq[nt & 1][0 + ks], af_[0 + ks], cwf, 0, 0, 0);
      cwb = __builtin_amdgcn_mfma_f32_16x16x32_bf16(wq[nt & 1][2 + ks], af_[2 + ks], cwb, 0, 0, 0);
      caf = __builtin_amdgcn_mfma_f32_16x16x32_bf16(wq[nt & 1][4 + ks], af_[4 + ks], caf, 0, 0, 0);
      cab = __builtin_amdgcn_mfma_f32_16x16x32_bf16(wq[nt & 1][6 + ks], af_[6 + ks], cab, 0, 0, 0);
    }
#pragma unroll
    for (int ks = 0; ks < 4; ++ks) cg = __builtin_amdgcn_mfma_f32_16x16x32_bf16(wq[nt & 1][8 + ks], af_[8 + ks], cg, 0, 0, 0);
    const float* prm = (const float*)(smem + PRM_OFF);
    const f32x4 w0f = *(const f32x4*)&prm[0 * 256 + c4], w0b = *(const f32x4*)&prm[1 * 256 + c4];
    const f32x4 a0f = *(const f32x4*)&prm[2 * 256 + c4], a0b = *(const f32x4*)&prm[3 * 256 + c4];
    const f32x4 kks = *(const f32x4*)&prm[4 * 256 + c4], kas = *(const f32x4*)&prm[5 * 256 + c4], rkc = *(const f32x4*)&prm[6 * 256 + c4];
    const f32x4 r4 = *(const f32x4*)&fr_[c4], k4 = *(const f32x4*)&fr_[256 + c4], v4 = *(const f32x4*)&fr_[512 + c4];
    float o_r[4], o_v[4], o_a[4], o_w0[4], o_w1[4], o_k0[4], o_k1[4], o_b0[4], o_b1[4], o_g[4];
#pragma unroll
    for (int j = 0; j < 4; ++j) {
      const float r = r4[j], k = k4[j], v = v4[j];
      const float sd0 = 0.6065306597126334f * sigm(w0f[j] + cwf[j]);
      const float sd1 = 0.6065306597126334f * sigm(w0b[j] + cwb[j]);
      const float a0 = sigm(a0f[j] + caf[j]), a1 = sigm(a0b[j] + cab[j]);
      const float kkn = k * kks[j] * rs;
      const float k0 = k * (1.f + (a0 - 1.f) * kas[j]), k1 = k * (1.f + (a1 - 1.f) * kas[j]);
      bsp += r * (k0 + k1) * rkc[j];
      o_r[j] = r; o_v[j] = v; o_a[j] = -kkn; o_w0[j] = sd0; o_w1[j] = sd1; o_k0[j] = k0; o_k1[j] = k1; o_b0[j] = kkn * a0; o_b1[j] = kkn * a1; o_g[j] = cg[j];
    }
#define PK4(a_) make_uint2(pack2(a_[0], a_[1]), pack2(a_[2], a_[3]))
    if ((nt & 1) == 0) {
      lo_[0] = PK4(o_r); lo_[1] = PK4(o_v); lo_[2] = PK4(o_a); lo_[3] = PK4(o_w0); lo_[4] = PK4(o_w1);
      lo_[5] = PK4(o_k0); lo_[6] = PK4(o_k1); lo_[7] = PK4(o_b0); lo_[8] = PK4(o_b1); lo_[9] = PK4(o_g);
    } else {
      const size_t o = (size_t)(t0 + tk) * 256 + h * 64 + (nt >> 1) * 32 + kc * 8;
#define ST8(dst, a_, li) do { const uint2 hi_ = PK4(a_); *(uint4*)&(dst)[o] = make_uint4(lo_[li].x, lo_[li].y, hi_.x, hi_.y); } while (0)
      ST8(SC + 0 * AS, o_r, 0); ST8(SC + 1 * AS, o_v, 1); ST8(SC + 2 * AS, o_a, 2); ST8(SC + 3 * AS, o_w0, 3); ST8(SC + 4 * AS, o_w1, 4);
      ST8(SC + 5 * AS, o_k0, 5); ST8(SC + 6 * AS, o_k1, 6); ST8(SC + 7 * AS, o_b0, 7); ST8(SC + 8 * AS, o_b1, 8); ST8(Gp, o_g, 9);
#undef ST8
    }
  }
  bsp += __shfl_xor(bsp, 16); bsp += __shfl_xor(bsp, 32);
#pragma unroll
  for (int pp = 0; pp < 2; ++pp) {
    const int c8 = h * 64 + pp * 32 + kc * 8;
    const f32x4 va = *(const f32x4*)&fr_[512 + c8], vb = *(const f32x4*)&fr_[512 + c8 + 4];
    float oa[4], ob2[4];
#pragma unroll
    for (int j = 0; j < 4; ++j) { oa[j] = bsp * va[j]; ob2[j] = bsp * vb[j]; }
    const uint2 l2 = PK4(oa), h2 = PK4(ob2);
    *(uint4*)&BON[(size_t)(t0 + tk) * 256 + c8] = make_uint4(l2.x, l2.y, h2.x, h2.y);
  }
#undef PK4
#undef LOADW
  __syncthreads();
}

DI void conv_item(const P& p, int l, int item) {
  float* hb = (float*)smem;
  float* ob = hb + 62 * 256;
  const int tid = otid();
  const int t0 = item * 32;
  int L, n0;
  if (t0 < TX) { L = 2048; n0 = t0 & 2047; } else { L = 256; n0 = (t0 - TX) & 255; }
  const u16* FC = (const u16*)(p.ws + WS_FC);
  const int c = tid & 255, ph = tid >> 8;
  {
    uint4 vv_[4], gg_[4];
#pragma unroll
    for (int q = 0; q < 4; ++q) {
      const int idx = q * NTHR + tid;
      const int rr = idx >> 5, cq = (idx & 31) * 8;
      const int n = n0 + rr - 15;
      const bool ok = rr < 62 && n >= 0 && n < L;
      const size_t row = ok ? (size_t)(t0 + rr - 15) : (size_t)t0;
      vv_[q] = *(const uint4*)&FC[row * 512 + cq]; gg_[q] = *(const uint4*)&FC[row * 512 + 256 + cq];
    }
#pragma unroll
    for (int q = 0; q < 4; ++q) {
      const int idx = q * NTHR + tid;
      const int rr = idx >> 5, cq = (idx & 31) * 8;
      const int n = n0 + rr - 15;
      const bool ok = n >= 0 && n < L;
      const unsigned vw[4] = {vv_[q].x, vv_[q].y, vv_[q].z, vv_[q].w}, gw[4] = {gg_[q].x, gg_[q].y, gg_[q].z, gg_[q].w};
      f32x4 h0 = {0.f, 0.f, 0.f, 0.f}, h1 = h0;
      if (ok) {
        h0[0] = blo(vw[0]) * sigm(blo(gw[0])); h0[1] = bhi(vw[0]) * sigm(bhi(gw[0])); h0[2] = blo(vw[1]) * sigm(blo(gw[1])); h0[3] = bhi(vw[1]) * sigm(bhi(gw[1]));
        h1[0] = blo(vw[2]) * sigm(blo(gw[2])); h1[1] = bhi(vw[2]) * sigm(bhi(gw[2])); h1[2] = blo(vw[3]) * sigm(blo(gw[3])); h1[3] = bhi(vw[3]) * sigm(bhi(gw[3]));
      }
      if (rr < 62) { *(f32x4*)&hb[rr * 256 + cq] = h0; *(f32x4*)&hb[rr * 256 + cq + 4] = h1; }
    }
  }
  __syncthreads();
  {
    float wreg[31];
#pragma unroll
    for (int w = 0; w < 31; ++w) wreg[w] = p.dw_w[(size_t)(l * 31 + w) * 256 + c];
    const float bias = p.dw_b[l * 256 + c];
    for (int pp = 0; pp < 16; ++pp) {
      const int pos = ph * 16 + pp;
      float a = bias;
#pragma unroll
      for (int w = 0; w < 31; ++w) a += hb[(pos + w) * 256 + c] * wreg[w];
      ob[pos * 256 + c] = a;
    }
  }
  __syncthreads();
  {
    const int lane = tid & 63, w = tid >> 6;
    u16* CAT = (u16*)(p.ws + WS_H);
    const float4 g4 = *(const float4*)&p.cln_g[l * 256 + lane * 4];
    const float4 b4 = *(const float4*)&p.cln_b[l * 256 + lane * 4];
#pragma unroll
    for (int q = 0; q < 4; ++q) {
      const int pos = w * 4 + q;
      const float4 v = *(const float4*)&ob[pos * 256 + lane * 4];
      const float mu = wave_sum(v.x + v.y + v.z + v.w) * (1.f / 256.f);
      const float d0 = v.x - mu, d1 = v.y - mu, d2 = v.z - mu, d3 = v.w - mu;
      const float var = wave_sum(d0 * d0 + d1 * d1 + d2 * d2 + d3 * d3) * (1.f / 256.f);
      const float rs = rsqrtf(var + 1e-5f);
      float y0 = d0 * rs * g4.x + b4.x, y1 = d1 * rs * g4.y + b4.y, y2 = d2 * rs * g4.z + b4.z, y3 = d3 * rs * g4.w + b4.w;
      y0 *= sigm(y0); y1 *= sigm(y1); y2 *= sigm(y2); y3 *= sigm(y3);
      uint2 o; o.x = pack2(y0, y1); o.y = pack2(y2, y3);
      *(uint2*)&CAT[(size_t)(t0 + pos) * 1024 + 256 + lane * 4] = o;
    }
  }
  __syncthreads();
}

DI void prepconv_phase(const P& p, int l, int rep) {
  const int nprep = T / 32, nconv = (l == 0 ? T : TX) / 32;
  unsigned* ctr = (unsigned*)(p.ws + WS_MISC) + 12 + l + 2 * rep;
  int* slot = (int*)(smem + LDS_CTL);
  {
    float* prm = (float*)(smem + PRM_OFF);
    for (int i = otid(); i < 7 * 256; i += NTHR) {
      const int a = i >> 8, c = i & 255;
      prm[i] = a < 2 ? p.w0[(l * 2 + a) * 256 + c] : a < 4 ? p.a0[(l * 2 + (a - 2)) * 256 + c] : a == 4 ? p.kk[l * 256 + c] : a == 5 ? p.ka[l * 256 + c] : p.rk[l * 256 + c];
    }
    __syncthreads();
  }
  int it = obid();
  while (it < nprep + nconv) {
    unsigned nx = 0u;
    if (otid() == 0) nx = atomicAdd(ctr, 1u);
    if (it < nprep) { if (!(rep && MIXPROBE == 4)) rwkv_prep_item(p, l, it); }
    else { if (!(rep && MIXPROBE == 3)) conv_item(p, l, it - nprep); }
    if (otid() == 0) *slot = (int)(gridDim.x + nx);
    __syncthreads();
    it = *slot;
    __syncthreads();
  }
}

DI int scan_row(int b, int dir, int gs) {
  if (dir == 0) return gs < 256 ? TX + b * 256 + gs : b * 2048 + (gs - 256);
  return gs < 256 ? TX + b * 256 + (255 - gs) : b * 2048 + (2047 - (gs - 256));
}

DI float allred8(float v) {
  v += dppx<0xB1>(v); v += dppx<0x4E>(v); v += dppx<0x141>(v);
  return v;
}
typedef float f2 __attribute__((ext_vector_type(2)));
constexpr int SST = 320;
constexpr int SOFF_V = 16 * SST;
constexpr int SOFF_BK = SOFF_V + 512;
constexpr int SBUF = SOFF_BK + 64;
struct ScanStep { f2 a[4], w[4], r[4], b[4], k[4]; };
DI void scan_block(const P& p, int sb) {
  const int tid = otid();
  const int chain = sb >> 1, rh = sb & 1, b = chain >> 3, h = (chain >> 1) & 3, dir = chain & 1;
  float* stg = (float*)smem;
  float* ybuf = stg + 2 * SBUF;
  const u16* SC = (const u16*)(p.ws + WS_SC);
  constexpr size_t AS = (size_t)T * 256;
  const bool is_comp = tid < 256;
#define LO(u) __uint_as_float((u) << 16)
#define HI(u) __uint_as_float((u) & 0xffff0000u)
  if (is_comp) {
    const int lane = tid & 63, cw = tid >> 6, jg = lane & 7, rl = cw * 8 + (lane >> 3);
    f2 S[4];
#pragma unroll
    for (int i = 0; i < 4; ++i) S[i] = (f2){0.f, 0.f};
    __syncthreads();
    for (int ch = 0; ch < 144; ++ch) {
      const float* st = stg + (ch & 1) * SBUF;
      float* yb = (jg == 0) ? (ybuf + (ch & 1) * 512 + rl) : (ybuf + 1024 + tid);
#define SLD(R, s) do { const float* d_ = st + (s) * SST + jg * 8; \
      { const float4 x_ = *(const float4*)&d_[0], y_ = *(const float4*)&d_[4]; R.a[0] = (f2){x_.x, x_.y}; R.a[1] = (f2){x_.z, x_.w}; R.a[2] = (f2){y_.x, y_.y}; R.a[3] = (f2){y_.z, y_.w}; } \
      { const float4 x_ = *(const float4*)&d_[64], y_ = *(const float4*)&d_[68]; R.w[0] = (f2){x_.x, x_.y}; R.w[1] = (f2){x_.z, x_.w}; R.w[2] = (f2){y_.x, y_.y}; R.w[3] = (f2){y_.z, y_.w}; } \
      { const float4 x_ = *(const float4*)&d_[128], y_ = *(const float4*)&d_[132]; R.r[0] = (f2){x_.x, x_.y}; R.r[1] = (f2){x_.z, x_.w}; R.r[2] = (f2){y_.x, y_.y}; R.r[3] = (f2){y_.z, y_.w}; } \
      { const float4 x_ = *(const float4*)&d_[192], y_ = *(const float4*)&d_[196]; R.b[0] = (f2){x_.x, x_.y}; R.b[1] = (f2){x_.z, x_.w}; R.b[2] = (f2){y_.x, y_.y}; R.b[3] = (f2){y_.z, y_.w}; } \
      { const float4 x_ = *(const float4*)&d_[256], y_ = *(const float4*)&d_[260]; R.k[0] = (f2){x_.x, x_.y}; R.k[1] = (f2){x_.z, x_.w}; R.k[2] = (f2){y_.x, y_.y}; R.k[3] = (f2){y_.z, y_.w}; } } while (0)
      float vv[16]; float bk[32];
#pragma unroll
      for (int q = 0; q < 4; ++q) { const float4 x_ = *(const float4*)&st[SOFF_V + rl * 16 + q * 4]; vv[q * 4] = x_.x; vv[q * 4 + 1] = x_.y; vv[q * 4 + 2] = x_.z; vv[q * 4 + 3] = x_.w; }
#pragma unroll
      for (int q = 0; q < 8; ++q) { const float4 x_ = *(const float4*)&st[SOFF_BK + q * 4]; bk[q * 4] = x_.x; bk[q * 4 + 1] = x_.y; bk[q * 4 + 2] = x_.z; bk[q * 4 + 3] = x_.w; }
      ScanStep cur, nxt;
      SLD(cur, 0);
#pragma unroll
      for (int s = 0; s < 16; ++s) {
        if (s + 1 < 16) SLD(nxt, s + 1);
        __builtin_amdgcn_sched_barrier(0);
        f2 t = S[0] * cur.a[0]; t = S[1] * cur.a[1] + t; t = S[2] * cur.a[2] + t; t = S[3] * cur.a[3] + t;
        f2 u = S[0] * cur.r[0]; u = S[1] * cur.r[1] + u; u = S[2] * cur.r[2] + u; u = S[3] * cur.r[3] + u;
        float sa = t.x + t.y, yp = u.x + u.y;
        sa = allred8(sa);
        yp = allred8(yp);
        const float v = vv[s];
        const float y = yp + sa * bk[2 * s] + v * bk[2 * s + 1];
        const f2 sa2 = (f2){sa, sa}, v2 = (f2){v, v};
#pragma unroll
        for (int i = 0; i < 4; ++i) S[i] = S[i] * cur.w[i] + (sa2 * cur.b[i] + v2 * cur.k[i]);
        yb[s * 32] = y;
        if (s + 1 < 16) cur = nxt;
      }
#undef SLD
      __syncthreads();
    }
    __syncthreads();
  } else {
    const int t2 = tid - 256, s_ = t2 >> 4, q_ = t2 & 15;
    const u16* Rp = SC, *Vp = SC + AS, *Ap = SC + 2 * AS, *Wp = SC + (3 + dir) * AS, *Kp = SC + (5 + dir) * AS, *Bp = SC + (7 + dir) * AS;
    u16* Y = (u16*)(p.ws + WS_Y) + (size_t)dir * AS;
    const int choff = h * 64 + 4 * q_;
    uint2 prA, pvA, paA, pwA, pkA, pbA, prB, pvB, paB, pwB, pkB, pbB;
#define SCAN_ISSUE(X, ch) do { const size_t o_ = (size_t)scan_row(b, dir, (ch) * 16 + s_) * 256 + choff; \
    pr##X = *(const uint2*)&Rp[o_]; pv##X = *(const uint2*)&Vp[o_]; pa##X = *(const uint2*)&Ap[o_]; \
    pw##X = *(const uint2*)&Wp[o_]; pk##X = *(const uint2*)&Kp[o_]; pb##X = *(const uint2*)&Bp[o_]; } while (0)
#define SCAN_COMMIT(X, bufi) do { float* d0_ = stg + (bufi) * SBUF; float* d_ = d0_ + s_ * SST; \
    const float4 r4 = make_float4(LO(pr##X.x), HI(pr##X.x), LO(pr##X.y), HI(pr##X.y)); \
    const float4 w4 = make_float4(__expf(-LO(pw##X.x)), __expf(-HI(pw##X.x)), __expf(-LO(pw##X.y)), __expf(-HI(pw##X.y))); \
    const float4 k4 = make_float4(LO(pk##X.x), HI(pk##X.x), LO(pk##X.y), HI(pk##X.y)); \
    const float4 b4 = make_float4(LO(pb##X.x), HI(pb##X.x), LO(pb##X.y), HI(pb##X.y)); \
    *(float4*)&d_[4 * q_] = make_float4(LO(pa##X.x), HI(pa##X.x), LO(pa##X.y), HI(pa##X.y)); \
    *(float4*)&d_[64 + 4 * q_] = w4; \
    *(float4*)&d_[128 + 4 * q_] = make_float4(w4.x * r4.x, w4.y * r4.y, w4.z * r4.z, w4.w * r4.w); \
    *(float4*)&d_[192 + 4 * q_] = b4; \
    *(float4*)&d_[256 + 4 * q_] = k4; \
    if ((q_ >> 3) == rh) { float* dv_ = d0_ + SOFF_V + 4 * (q_ & 7) * 16 + s_; dv_[0] = LO(pv##X.x); dv_[16] = HI(pv##X.x); dv_[32] = LO(pv##X.y); dv_[48] = HI(pv##X.y); } \
    float br_ = b4.x * r4.x + b4.y * r4.y + b4.z * r4.z + b4.w * r4.w; \
    float kr_ = k4.x * r4.x + k4.y * r4.y + k4.z * r4.z + k4.w * r4.w; \
    br_ = allred16(br_); kr_ = allred16(kr_); \
    if (q_ == 0) *(float2*)&d0_[SOFF_BK + 2 * s_] = make_float2(br_, kr_); } while (0)
#define SCAN_YSTORE(ch) do { const float* yb_ = ybuf + ((ch) & 1) * 512; \
    const float2 yv_ = *(const float2*)&yb_[s_ * 32 + 2 * q_]; \
    const int row_ = scan_row(b, dir, (ch) * 16 + s_); \
    *(unsigned*)&Y[(size_t)row_ * 256 + h * 64 + rh * 32 + 2 * q_] = pack2(yv_.x, yv_.y); } while (0)
    SCAN_ISSUE(A, 0);
    SCAN_COMMIT(A, 0);
    SCAN_ISSUE(B, 1);
    __syncthreads();
    for (int ch = 0; ch < 144; ch += 2) {
      SCAN_COMMIT(B, 1);
      if (ch + 2 < 144) SCAN_ISSUE(A, ch + 2);
      if (ch > 0) SCAN_YSTORE(ch - 1);
      __syncthreads();
      if (ch + 2 < 144) SCAN_COMMIT(A, 0);
      if (ch + 3 < 144) SCAN_ISSUE(B, ch + 3);
      SCAN_YSTORE(ch);
      __syncthreads();
    }
    SCAN_YSTORE(143);
    __syncthreads();
#undef SCAN_ISSUE
#undef SCAN_COMMIT
#undef SCAN_YSTORE
  }
}

#define MFMA32(a, b, c) __builtin_amdgcn_mfma_f32_32x32x16_bf16((a), (b), (c), 0, 0, 0)
constexpr int ATT_BUF = 36864;
DI void attn_item(const P& p, int l, int item) {
  const int tid = otid(), lane = tid & 63, wave = tid >> 6, m = wave >> 2, qw = wave & 3, r = lane & 31, hh = lane >> 5;
  int qrow0, b, h, key0, nk;
  if (item < 512) { b = item >> 6; h = (item >> 4) & 3; qrow0 = b * 2048 + (item & 15) * 128; key0 = 0; nk = 2304; }
  else { const int it = item - 512; b = it >> 3; h = (it >> 1) & 3; qrow0 = TX + b * 256 + (it & 1) * 128; key0 = 2048; nk = 256; }
  const u16* Q = (const u16*)(p.ws + WS_Q);
  const u16* KK = (const u16*)(p.ws + WS_KK) + ((size_t)b * 2304 + key0) * 512 + h * 128;
  const u16* VT = (const u16*)(p.ws + WS_VT) + ((size_t)(b * 4 + h) * 128) * 2304 + key0;
  bf16x8 qf[4];
  {
    const u16* qp = Q + (size_t)(qrow0 + qw * 32 + r) * 512 + h * 128 + m * 64 + hh * 8;
#pragma unroll
    for (int ks = 0; ks < 4; ++ks) qf[ks] = *(const bf16x8*)&qp[ks * 16];
  }
  uint4 g0 = make_uint4(0u, 0u, 0u, 0u), g1 = g0, g2 = g0, g3 = g0;
  const int ck0 = tid, ck1 = tid + 512;
  const int kdst0 = (ck0 >> 9) * 9216 + ((ck0 >> 3) & 63) * 144 + (ck0 & 7) * 16;
  const int kdst1 = (ck1 >> 9) * 9216 + ((ck1 >> 3) & 63) * 144 + (ck1 & 7) * 16;
  const size_t ksrc0 = (size_t)((ck0 >> 3) & 63) * 512 + (ck0 >> 9) * 64 + (ck0 & 7) * 8;
  const size_t ksrc1 = (size_t)((ck1 >> 3) & 63) * 512 + (ck1 >> 9) * 64 + (ck1 & 7) * 8;
  const int vdst0 = 18432 + (ck0 >> 3) * 144 + (ck0 & 7) * 16;
  const int vdst1 = 18432 + (ck1 >> 3) * 144 + (ck1 & 7) * 16;
  const size_t vsrc0 = (size_t)(ck0 >> 3) * 2304 + (ck0 & 7) * 8;
  const size_t vsrc1 = (size_t)(ck1 >> 3) * 2304 + (ck1 & 7) * 8;
#define ATT_LOAD(t) do { const u16* kp_ = KK + (size_t)(t) * 64 * 512; const u16* vp_ = VT + (t) * 64; \
    g0 = *(const uint4*)&kp_[ksrc0]; g1 = *(const uint4*)&kp_[ksrc1]; \
    g2 = *(const uint4*)&vp_[vsrc0]; g3 = *(const uint4*)&vp_[vsrc1]; } while (0)
#define ATT_STORE(bi) do { unsigned char* bb_ = smem + (bi) * ATT_BUF; \
    *(uint4*)(bb_ + kdst0) = g0; *(uint4*)(bb_ + kdst1) = g1; \
    *(uint4*)(bb_ + vdst0) = g2; *(uint4*)(bb_ + vdst1) = g3; } while (0)
#define ATT_QK(kb) do { _Pragma("unroll") for (int ks = 0; ks < 4; ++ks) { \
      const bf16x8 a0_ = *(const bf16x8*)((kb) + r * 144 + ks * 32 + hh * 16); \
      const bf16x8 a1_ = *(const bf16x8*)((kb) + (32 + r) * 144 + ks * 32 + hh * 16); \
      s0 = MFMA32(a0_, qf[ks], s0); s1 = MFMA32(a1_, qf[ks], s1); } } while (0)
#define ATT_PV1(vb, kt, s, PF) do { _Pragma("unroll") for (int nt = 0; nt < 4; ++nt) { \
        const unsigned char* vp_ = (vb) + (nt * 32 + r) * 144 + ((kt) * 32 + 16 * (s) + 4 * hh) * 2; \
        const s16x4 lo_ = *(const s16x4*)vp_; const s16x4 hi_ = *(const s16x4*)(vp_ + 16); \
        const bf16x8 vf_ = __builtin_shufflevector(lo_, hi_, 0, 1, 2, 3, 4, 5, 6, 7); \
        o[nt] = MFMA32(vf_, PF, o[nt]); } } while (0)
#define ATT_PV(vb) do { ATT_PV1(vb, 0, 0, pf0); ATT_PV1(vb, 0, 1, pf1); ATT_PV1(vb, 1, 0, pf2); ATT_PV1(vb, 1, 1, pf3); } while (0)
  const int ntile = nk / 64;
  ATT_LOAD(0);
  ATT_STORE(0);
  __syncthreads();
  float mrun;
  {
    f32x16 s0, s1;
#pragma unroll
    for (int j = 0; j < 16; ++j) { s0[j] = 0.f; s1[j] = 0.f; }
    const unsigned char* kb = smem + m * 9216;
    ATT_QK(kb);
    float mx = s0[0];
#pragma unroll
    for (int j = 1; j < 16; ++j) mx = fmaxf(mx, s0[j]);
#pragma unroll
    for (int j = 0; j < 16; ++j) mx = fmaxf(mx, s1[j]);
    mrun = fmaxf(mx, __shfl_xor(mx, 32));
  }
  f32x16 o[4];
#pragma unroll
  for (int i = 0; i < 4; ++i)
#pragma unroll
    for (int j = 0; j < 16; ++j) o[i][j] = 0.f;
  float lrun = 0.f;
  bf16x8 pf0, pf1, pf2, pf3;
#pragma unroll
  for (int j = 0; j < 8; ++j) { pf0[j] = 0; pf1[j] = 0; pf2[j] = 0; pf3[j] = 0; }
  for (int t = 0; t <= ntile; ++t) {
    if (t + 1 < ntile) ATT_LOAD(t + 1);
    if (m == 1 && t > 0) { const unsigned char* vb = smem + ((t - 1) % 3) * ATT_BUF + 18432; ATT_PV(vb); }
    if (t < ntile) {
      const unsigned char* kb = smem + (t % 3) * ATT_BUF + m * 9216;
      f32x16 s0, s1;
      const float nm = -mrun;
#pragma unroll
      for (int j = 0; j < 16; ++j) { s0[j] = nm; s1[j] = nm; }
      ATT_QK(kb);
      float mx = s0[0];
#pragma unroll
      for (int j = 1; j < 16; ++j) mx = fmaxf(mx, s0[j]);
#pragma unroll
      for (int j = 0; j < 16; ++j) mx = fmaxf(mx, s1[j]);
      if (__builtin_amdgcn_ballot_w64(mx > 8.f) != 0ull) {
        const float mo = fmaxf(mx, __shfl_xor(mx, 32));
        const float delta = fmaxf(mo, 0.f);
        const float alpha = __builtin_amdgcn_exp2f(-delta);
        mrun += delta; lrun *= alpha;
#pragma unroll
        for (int i = 0; i < 4; ++i)
#pragma unroll
          for (int j = 0; j < 16; ++j) o[i][j] *= alpha;
#pragma unroll
        for (int j = 0; j < 16; ++j) { s0[j] -= delta; s1[j] -= delta; }
      }
      float ls = 0.f;
#pragma unroll
      for (int j = 0; j < 16; ++j) { s0[j] = __builtin_amdgcn_exp2f(s0[j]); ls += s0[j]; }
#pragma unroll
      for (int j = 0; j < 16; ++j) { s1[j] = __builtin_amdgcn_exp2f(s1[j]); ls += s1[j]; }
      lrun += ls;
#pragma unroll
      for (int j = 0; j < 8; ++j) { pf0[j] = (short)f2bf(s0[j]); pf1[j] = (short)f2bf(s0[8 + j]); pf2[j] = (short)f2bf(s1[j]); pf3[j] = (short)f2bf(s1[8 + j]); }
    }
    if (m == 0 && t < ntile) { const unsigned char* vb = smem + (t % 3) * ATT_BUF + 18432; ATT_PV(vb); }
    if (t + 1 < ntile) ATT_STORE((t + 1) % 3);
    __syncthreads();
  }
  const float lt = lrun + __shfl_xor(lrun, 32);
  const float inv = 1.f / lt;
  float* ob = (float*)smem;
  if (m == 1) {
#pragma unroll
    for (int nt = 0; nt < 4; ++nt)
#pragma unroll
      for (int j = 0; j < 16; ++j) ob[((qw * 4 + nt) * 16 + j) * 64 + lane] = o[nt][j] * inv;
  }
  __syncthreads();
  if (m == 0) {
    const float* mf = (const float*)(p.ws + WS_MISC);
    const float lamv = mf[l], li = mf[2 + l];
    float ss = 0.f;
#pragma unroll
    for (int nt = 0; nt < 4; ++nt)
#pragma unroll
      for (int j = 0; j < 16; ++j) {
        const float dv = o[nt][j] * inv - lamv * ob[((qw * 4 + nt) * 16 + j) * 64 + lane];
        o[nt][j] = dv;
        ss += dv * dv;
      }
    ss += __shfl_xor(ss, 32);
    const float rs = rsqrtf(ss * (1.f / 128.f) + 1e-5f) * (1.f - li);
    u16* CAT = (u16*)(p.ws + WS_H) + (size_t)(qrow0 + qw * 32 + r) * 1024 + 512 + h * 128;
    const float* gp = p.dng + l * 128;
#pragma unroll
    for (int nt = 0; nt < 4; ++nt) {
      uint2 ch[4];
#pragma unroll
      for (int g = 0; g < 4; ++g) {
        const int vd = nt * 32 + 8 * g + 4 * hh;
        const float4 g4 = *(const float4*)&gp[vd];
        ch[g].x = pack2(o[nt][4 * g + 0] * rs * g4.x, o[nt][4 * g + 1] * rs * g4.y);
        ch[g].y = pack2(o[nt][4 * g + 2] * rs * g4.z, o[nt][4 * g + 3] * rs * g4.w);
      }
#pragma unroll
      for (int q = 0; q < 2; ++q) {
        const uint2 snd = hh ? ch[2 * q] : ch[2 * q + 1];
        const uint2 rcv = make_uint2((unsigned)__shfl_xor((int)snd.x, 32), (unsigned)__shfl_xor((int)snd.y, 32));
        const uint4 o4 = hh ? make_uint4(rcv.x, rcv.y, ch[2 * q + 1].x, ch[2 * q + 1].y) : make_uint4(ch[2 * q].x, ch[2 * q].y, rcv.x, rcv.y);
        *(uint4*)&CAT[nt * 32 + 16 * q + 8 * hh] = o4;
      }
    }
  }
  __syncthreads();
#undef ATT_LOAD
#undef ATT_STORE
#undef ATT_QK
#undef ATT_PV
#undef ATT_PV1
}

DI void mixer_phase(const P& p, int l, int rep) {
  if (!(rep && MIXPROBE == 1)) for (int sb = obid(); sb < 128; sb += gridDim.x) scan_block(p, sb);
  if (rep && MIXPROBE == 2) return;
  const int nitems = l == 0 ? 576 : 512;
  unsigned* ctr = (unsigned*)(p.ws + WS_MISC) + 8 + l + 2 * rep;
  int* slot = (int*)(smem + LDS_CTL);
  const int nstat = (int)gridDim.x > 128 ? (int)gridDim.x - 128 : 0;
  int it;
  if (obid() >= 128) it = obid() - 128;
  else {
    if (otid() == 0) *slot = nstat + (int)atomicAdd(ctr, 1u);
    __syncthreads();
    it = *slot;
    __syncthreads();
  }
  while (it < nitems) {
    unsigned nx = 0u;
    if (otid() == 0) nx = atomicAdd(ctr, 1u);
    attn_item(p, l, it);
    if (otid() == 0) *slot = nstat + (int)nx;
    __syncthreads();
    it = *slot;
    __syncthreads();
  }
}

DI void finish_phase(const P& p, int l, int rows) {
  const int lane = otid() & 63, w = otid() >> 6;
  const u16* Y = (const u16*)(p.ws + WS_Y);
  const u16* Gp = (const u16*)(p.ws + WS_G);
  const u16* BON = (const u16*)(p.ws + WS_BON);
  u16* CAT = (u16*)(p.ws + WS_H);
  constexpr size_t AS = (size_t)T * 256;
  const float4 g4 = *(const float4*)&p.ln_g[l * 256 + lane * 4];
  const float4 b4 = *(const float4*)&p.ln_b[l * 256 + lane * 4];
  for (int row = obid() * 8 + w; row < rows; row += gridDim.x * 8) {
    const size_t o = (size_t)row * 256 + lane * 4;
    const uint2 yf = *(const uint2*)&Y[o], yb = *(const uint2*)&Y[AS + o];
    const uint2 gg = *(const uint2*)&Gp[o], bo = *(const uint2*)&BON[o];
    float y0 = LO(yf.x) + LO(yb.x), y1 = HI(yf.x) + HI(yb.x), y2 = LO(yf.y) + LO(yb.y), y3 = HI(yf.y) + HI(yb.y);
    float s = y0 + y1 + y2 + y3;
    s = allred16(s);
    const float mu = s * (1.f / 64.f);
    y0 -= mu; y1 -= mu; y2 -= mu; y3 -= mu;
    float vs = y0 * y0 + y1 * y1 + y2 * y2 + y3 * y3;
    vs = allred16(vs);
    const float rs = rsqrtf(vs * (1.f / 64.f) + 64e-5f);
    const float o0 = (y0 * rs * g4.x + b4.x + LO(bo.x)) * LO(gg.x);
    const float o1 = (y1 * rs * g4.y + b4.y + HI(bo.x)) * HI(gg.x);
    const float o2 = (y2 * rs * g4.z + b4.z + LO(bo.y)) * LO(gg.y);
    const float o3 = (y3 * rs * g4.w + b4.w + HI(bo.y)) * HI(gg.y);
    uint2 ov; ov.x = pack2(o0, o1); ov.y = pack2(o2, o3);
    *(uint2*)&CAT[(size_t)row * 1024 + lane * 4] = ov;
  }
}


#define XB_TMO      128
#define XB_XCNT(j)  (256  + 64 * (j))
#define XB_XSUB(j)  (1280 + 64 * (j))
#define XB_XGEN(j)  (2304 + 64 * (j))
#define XB_TOP      3328
#define XB_TOPGEN   3392
#define XB_SPIN_CAP (1u << 20)
DI unsigned xb_ld(unsigned* p) { return __hip_atomic_load(p, __ATOMIC_RELAXED, __HIP_MEMORY_SCOPE_AGENT); }
DI unsigned xb_add(unsigned* p, unsigned v) { return __hip_atomic_fetch_add(p, v, __ATOMIC_RELAXED, __HIP_MEMORY_SCOPE_AGENT); }
DI unsigned xb_xcc_id() { return (unsigned)__builtin_amdgcn_s_getreg((3 << 11) | 20) & 0xFu; }
#define XB_SPIN(cond, bar) do { unsigned _sp = 0; while (cond) { __builtin_amdgcn_s_sleep(1); \
    if ((++_sp & 255u) == 0u) { if (xb_ld(&(bar)[XB_TMO])) break; if (_sp > XB_SPIN_CAP) { atomicAdd(&(bar)[XB_TMO], 1u); break; } } } } while (0)
struct XcdBarrier { unsigned* bar; unsigned x; volatile LAS unsigned* st; };
DI XcdBarrier xcd_barrier_post(unsigned* bar, volatile LAS unsigned* st) {
  XcdBarrier b; b.bar = bar; b.x = xb_xcc_id(); b.st = st;
  if (threadIdx.x == 0) (void)xb_add(&bar[XB_XCNT(b.x)], 1u);
  return b;
}
DI void xcd_barrier_complete(unsigned* bar, unsigned x, unsigned& nloc, unsigned& nx) {
  const unsigned G = gridDim.x * gridDim.y * gridDim.z;
  unsigned sum, cnt, mine, sp = 0u;
  for (;;) {
    sum = 0u; cnt = 0u; mine = 0u;
#pragma unroll
    for (unsigned j = 0; j < 16; ++j) { const unsigned c = xb_ld(&bar[XB_XCNT(j)]); sum += c; cnt += (c > 0u) ? 1u : 0u; mine = (j == x) ? c : mine; }
    if (sum == G) break;
    __builtin_amdgcn_s_sleep(1);
    if ((++sp & 255u) == 0u) { if (xb_ld(&bar[XB_TMO])) break; if (sp > XB_SPIN_CAP) { atomicAdd(&bar[XB_TMO], 1u); break; } }
  }
  nloc = mine > 0u ? mine : 1u; nx = cnt > 0u ? cnt : 1u;
}
DI void xcd_barrier(const XcdBarrier& b) {
  asm volatile("s_waitcnt vmcnt(0)" ::: "memory");
  __syncthreads();
  if (threadIdx.x == 0) {
    unsigned* bar = b.bar;
    __builtin_amdgcn_s_waitcnt(0);
    unsigned nloc = b.st[0], nx = b.st[1];
    if (nloc == 0u) { xcd_barrier_complete(bar, b.x, nloc, nx); b.st[0] = nloc; b.st[1] = nx; }
    const unsigned old = xb_add(&bar[XB_XSUB(b.x)], 1u);
    const unsigned gen = old / nloc;
    if (old + 1u == (gen + 1u) * nloc) {
      __builtin_amdgcn_fence(__ATOMIC_RELEASE, "agent");
      asm volatile("s_waitcnt vmcnt(0)" ::: "memory");
      const unsigned og = xb_add(&bar[XB_TOP], 1u);
      const unsigned tg = og / nx;
      if (og + 1u == (tg + 1u) * nx) xb_add(&bar[XB_TOPGEN], 1u);
      else XB_SPIN(xb_ld(&bar[XB_TOPGEN]) == tg, bar);
      __builtin_amdgcn_fence(__ATOMIC_ACQUIRE, "agent");
      xb_add(&bar[XB_XGEN(b.x)], 1u);
      asm volatile("s_waitcnt vmcnt(0)" ::: "memory");
    } else {
      XB_SPIN(xb_ld(&bar[XB_XGEN(b.x)]) == gen, bar);
      __builtin_amdgcn_fence(__ATOMIC_ACQUIRE, "agent");
      asm volatile("s_waitcnt vmcnt(0)" ::: "memory");
    }
  }
  __syncthreads();
}

constexpr int NPHASE = 26;
#ifndef REPMASK
#define REPMASK 0
#endif
#ifndef SYNCX
#define SYNCX 0
#endif
__global__ void __launch_bounds__(NTHR) mega(P p) {
  cg::grid_group grid = cg::this_grid();
  if (p.ph_hi > 1000) grid.sync();
  volatile LAS unsigned* stw = (volatile LAS unsigned*)((LAS unsigned char*)smem + LDS_CTL + 16);
  if (threadIdx.x < 4) stw[threadIdx.x] = 0u;
  __syncthreads();
  const XcdBarrier xb = xcd_barrier_post((unsigned*)(p.ws + WS_BAR), stw);
#define GSYNC() xcd_barrier(xb)
  const u16* H = (const u16*)(p.ws + WS_H);
  const u16* ACT = (const u16*)(p.ws + WS_ACT);
  const u16* WIN = (const u16*)(p.ws + WS_WIN);
  const u16* WOUT = (const u16*)(p.ws + WS_WOUT);
  const u16* WMIN = (const u16*)(p.ws + WS_MIN);
  const u16* WMOUT = (const u16*)(p.ws + WS_MOUT);
  for (int ph = p.ph_lo; ph < p.ph_hi; ++ph) {
    if (ph == 0) {
      prep_phase(p, 0);
    } else if (ph == 25) {
      final_phase(p);
    } else {
      const int l = (ph - 1) / 12, s = (ph - 1) % 12;
      const int Mx = (l == 1) ? TX : T;
      float* xo = p.out;
      u16* ACTw = (u16*)(p.ws + WS_ACT);
      for (int rep = 0; rep < 1 + ((REPMASK >> s) & 1); ++rep) {
      switch (s) {
        case 0: if (rep == 0 && l == 1) prep_phase(p, 1); norm_phase(p, l, 0, 0, l == 0, T, (l == 1 && rep == 0) ? 8 : 0); break;
        case 1: gemm_phase(Gemm{H, WIN, T, 5632, 1024}, EpiSwiglu{ACTw}); break;
        case 2: gemm_phase(Gemm{ACT, WOUT, T, 1024, 2816}, EpiResid{xo, p.ws, l, 2, 1, 1, l == 0 ? p.x : (const float*)xo}, TX, 8); break;
        case 3: norm_phase(p, l, 1, 3, false, T, rep == 0 ? 8 : 0, l == 0); break;
        case 4: gemm_phase(Gemm{H, WMIN, T, PINP, 1024}, EpiMix{p.ws}); break;
        case 5: prepconv_phase(p, l, rep); break;
        case 6: mixer_phase(p, l, rep); break;
        case 7: finish_phase(p, l, Mx); break;
        case 8: gemm_phase(Gemm{H, WMOUT, Mx, 1024, 1024}, EpiResid{xo, p.ws, l, 5, 0, l == 0, (const float*)xo}, TX, l == 0 ? 4 : 0); break;
        case 9: norm_phase(p, l, 2, 6, false, Mx, (l == 0 && rep == 0) ? 4 : 0); break;
        case 10: gemm_phase(Gemm{H, WIN + (size_t)5632 * 1024, Mx, 5632, 1024}, EpiSwiglu{ACTw}); break;
        case 11: gemm_phase(Gemm{ACT, WOUT + (size_t)1024 * 2816, Mx, 1024, 2816}, EpiResid{xo, p.ws, l, 8, 1, l == 0, (const float*)xo}, TX, l == 0 ? 8 : 0); break;
      }
      if (rep + 1 < 1 + ((REPMASK >> s) & 1)) GSYNC();
      }
    }
    if (ph + 1 < p.ph_hi) { GSYNC(); for (int q = 0; q < SYNCX; ++q) GSYNC(); }
  }
}

extern "C" void kernel_launch(void* const* d_in, const int* in_sizes, int n_in, void* d_out, int out_size, void* d_ws,
                              size_t ws_size, hipStream_t stream) {
  static int grid = 0;
  if (grid == 0) {
    if (n_in != 29 || ws_size < WS_END) {
      fprintf(stderr, "kernel_launch: need 29 inputs and %zu bytes of ws; got %d, %zu\n", (size_t)WS_END, n_in, ws_size);
      grid = -1; return;
    }
    int dev = 0, cus = 0, per_cu = 0;
    hipGetDevice(&dev);
    hipDeviceGetAttribute(&cus, hipDeviceAttributeMultiprocessorCount, dev);
    if (hipFuncSetAttribute((const void*)mega, hipFuncAttributeMaxDynamicSharedMemorySize, LDS_BYTES) != hipSuccess) {
      fprintf(stderr, "kernel_launch: hipFuncSetAttribute failed\n"); grid = -1; return;
    }
    hipOccupancyMaxActiveBlocksPerMultiprocessor(&per_cu, (const void*)mega, NTHR, LDS_BYTES);
    if (per_cu < 1) { fprintf(stderr, "kernel_launch: occupancy query says %d blocks/CU\n", per_cu); per_cu = 1; }
    (void)hipGetLastError();
    grid = cus;
  }
  if (grid < 0) return;
  P p{};
  const float** pp = (const float**)&p;
  for (int i = 0; i < 29; ++i) pp[i] = (const float*)d_in[i];
  p.out = (float*)d_out;
  p.ws = (unsigned char*)d_ws;
  p.ph_lo = 0; p.ph_hi = NPHASE;
  if (hipMemsetAsync((char*)d_ws + WS_BAR, 0, BAR_BYTES, stream) != hipSuccess) { fprintf(stderr, "kernel_launch: memset failed\n"); return; }
  void* args[] = {&p};
  hipError_t e = hipLaunchCooperativeKernel((const void*)mega, dim3(grid), dim3(NTHR), args, LDS_BYTES, stream);
  if (e != hipSuccess) fprintf(stderr, "cooperative launch failed: %s (grid %d)\n", hipGetErrorString(e), grid);
}
```

```cpp
#include <hip/hip_runtime.h>
#include <hip/hip_bf16.h>
#include <hip/hip_cooperative_groups.h>
#include <cstdio>
namespace cg = cooperative_groups;

typedef unsigned short u16;
using bf16x8 = __attribute__((ext_vector_type(8))) short;
using s16x4 = __attribute__((ext_vector_type(4))) short;
using f32x4 = __attribute__((ext_vector_type(4))) float;
using f32x16 = __attribute__((ext_vector_type(16))) float;
#define DI __device__ __forceinline__

constexpr int D = 1024, TX = 16384, TCX = 2048, T = 18432, DFF = 2816, PINP = 3328;
constexpr int NTHR = 512;
#define MIXPROBE 0
constexpr int LDS_BYTES = 131072 + 256;
constexpr int LDS_CTL = 131072;

constexpr size_t WS_WIN = 0;
constexpr size_t WS_WOUT = WS_WIN + 2ull * 5632 * 1024 * 2;
constexpr size_t WS_MIN = WS_WOUT + 2ull * 1024 * 2816 * 2;
constexpr size_t WS_MOUT = WS_MIN + 3328ull * 1024 * 2;
constexpr size_t WS_XC = WS_MOUT + 1024ull * 1024 * 2;
constexpr size_t WS_MOD = WS_XC + 2048ull * 1024 * 4;
constexpr size_t WS_ROPE = WS_MOD + 2ull * 9 * 9216 * 4;
constexpr size_t WS_MISC = WS_ROPE + 64 * 16 * 2 * 4;
constexpr size_t WS_BAR = WS_MISC + 256;
constexpr size_t BAR_BYTES = 3456 * 4;
constexpr size_t WS_LORA = WS_BAR + 16384;
constexpr size_t WS_H = WS_LORA + 196608ull * 2;
constexpr size_t WS_R1 = WS_H + (size_t)T * 1024 * 2;
constexpr size_t SZ256 = (size_t)T * 256 * 2;
constexpr size_t WS_ACT = WS_R1;
constexpr size_t WS_FR = WS_R1;
constexpr size_t WS_Y = WS_R1;
constexpr size_t WS_SLAB = WS_R1 + 112ull * 1024 * 1024;
constexpr size_t WS_FC = WS_FR + (size_t)T * 1152 * 2;
constexpr size_t WS_Q = WS_FC + (size_t)T * 512 * 2;
constexpr size_t WS_KK = WS_Q + (size_t)T * 512 * 2;
constexpr size_t WS_VT = WS_KK + (size_t)T * 512 * 2;
constexpr size_t WS_SC = WS_VT + (size_t)T * 512 * 2;
constexpr size_t WS_G = WS_SC + 9 * SZ256;
constexpr size_t WS_BON = WS_G + SZ256;
constexpr size_t WS_END = WS_BON + SZ256;

struct P {
  const float *x, *c, *ctx, *c_ctx, *ada_w, *ada_b, *norm_g, *ffn_w_in, *ffn_w_out, *mix_w_in, *mix_w_out,
      *mu, *w0, *w2, *a0, *a2, *g2, *kk, *ka, *rk, *ln_g, *ln_b, *dw_w, *dw_b, *cln_g, *cln_b, *lam, *dng, *final_g;
  float* out;
  unsigned char* ws;
  int ph_lo, ph_hi;
};

extern __shared__ __attribute__((aligned(16))) unsigned char smem[];

DI int otid() { int t = threadIdx.x; asm volatile("" : "+v"(t)); return t; }
DI int obid() { int b = blockIdx.x; asm volatile("" : "+s"(b)); return b; }
DI u16 f2bf(float x) { __bf16 b = (__bf16)x; return __builtin_bit_cast(u16, b); }
DI float bf2f(u16 h) { return __uint_as_float(((unsigned)h) << 16); }
DI unsigned pack2(float a, float b) { return (unsigned)f2bf(a) | ((unsigned)f2bf(b) << 16); }
DI float sigm(float x) { return __builtin_amdgcn_rcpf(1.f + __builtin_amdgcn_exp2f(-1.4426950408889634f * x)); }
DI float wave_sum(float v);
template <int CTRL> DI float dppx(float v) {
  return __int_as_float(__builtin_amdgcn_update_dpp(0, __float_as_int(v), CTRL, 0xF, 0xF, true));
}
DI float allred16(float v) {
  v += dppx<0xB1>(v); v += dppx<0x4E>(v); v += dppx<0x141>(v); v += dppx<0x140>(v);
  return v;
}
DI float wave_sum(float v) {
  v = allred16(v);
  v += __shfl_xor(v, 16);
  v += __shfl_xor(v, 32);
  return v;
}
DI float* xrow(const P& p, int row) {
  return row < TX ? p.out + (size_t)row * D : (float*)(p.ws + WS_XC) + (size_t)(row - TX) * D;
}

DI void tr_tile(const float* W, int N, int K, u16* Wt, int kt, int ntile, int mode) {
  float* tile = (float*)smem;
  const int tid = otid();
  const int k0 = kt * 64, np0 = ntile * 64;
  int n0 = np0; bool valid = true;
  if (mode == 1) { int tl = np0 >> 8, half = (np0 >> 7) & 1, jj = np0 & 127; n0 = half * DFF + tl * 128 + jj; }
  if (mode == 2) { valid = np0 < 3200; }
  {
    const int kr = tid >> 4, nc = (tid & 15) * 4;
#pragma unroll
    for (int pz = 0; pz < 2; ++pz) {
      const int k = kr + 32 * pz;
      float4 v = make_float4(0.f, 0.f, 0.f, 0.f);
      if (valid) v = *(const float4*)&W[(size_t)(k0 + k) * N + n0 + nc];
      tile[k * 65 + nc + 0] = v.x; tile[k * 65 + nc + 1] = v.y; tile[k * 65 + nc + 2] = v.z; tile[k * 65 + nc + 3] = v.w;
    }
  }
  __syncthreads();
  {
    const int np = tid >> 3, ks = (tid & 7) * 8;
    uint4 o;
    o.x = pack2(tile[(ks + 0) * 65 + np], tile[(ks + 1) * 65 + np]);
    o.y = pack2(tile[(ks + 2) * 65 + np], tile[(ks + 3) * 65 + np]);
    o.z = pack2(tile[(ks + 4) * 65 + np], tile[(ks + 5) * 65 + np]);
    o.w = pack2(tile[(ks + 6) * 65 + np], tile[(ks + 7) * 65 + np]);
    *(uint4*)&Wt[(size_t)(np0 + np) * K + k0 + ks] = o;
  }
  __syncthreads();
}

DI void mod_item(const P& p, int idx) {
  float* cond = (float*)smem;
  float* red = cond + 9216;
  const int tid = otid(), lane = tid & 63, w = tid >> 6;
  const int l2 = idx / 144, n0 = (idx % 144) * 64;
  for (int i = tid; i < 9216; i += NTHR) {
    int m = i >> 10, k = i & 1023;
    float v = m < 8 ? p.c[m * 1024 + k] : p.c_ctx[k];
    cond[i] = v * sigm(v);
  }
  __syncthreads();
  float acc[9];
#pragma unroll
  for (int m = 0; m < 9; ++m) acc[m] = 0.f;
  const float* wp = p.ada_w + ((size_t)l2 * 1024 + w * 128) * 9216 + n0 + lane;
#pragma unroll 4
  for (int k = 0; k < 128; ++k) {
    float wv = wp[(size_t)k * 9216];
#pragma unroll
    for (int m = 0; m < 9; ++m) acc[m] += cond[m * 1024 + w * 128 + k] * wv;
  }
#pragma unroll
  for (int m = 0; m < 9; ++m) red[(w * 9 + m) * 64 + lane] = acc[m];
  __syncthreads();
  float* mod = (float*)(p.ws + WS_MOD);
  for (int o = tid; o < 576; o += NTHR) {
    int m = o >> 6, ln = o & 63;
    float s = 0.f;
#pragma unroll
    for (int ww = 0; ww < 8; ++ww) s += red[(ww * 9 + m) * 64 + ln];
    mod[(size_t)(l2 * 9 + m) * 9216 + n0 + ln] = s + p.ada_b[l2 * 9216 + n0 + ln];
  }
  __syncthreads();
}

DI void misc_item(const P& p) {
  const int tid = otid();
  float* rope = (float*)(p.ws + WS_ROPE);
  for (int i = tid; i < 1024; i += NTHR) {
    int pos = i >> 4, f = i & 15;
    float inv = exp2f(-(float)f * (13.287712379549449f / 16.f));
    float ang = (float)pos * inv;
    float kq = rintf(ang * 0.15915494309189535f);
    float r = fmaf(-kq, 6.28125f, ang);
    r = fmaf(-kq, 1.9353071795864769e-3f, r);
    rope[i * 2 + 0] = cosf(r);
    rope[i * 2 + 1] = sinf(r);
  }
  if (tid < 2) {
    const float* lv = p.lam + tid * 256;
    float s1 = 0.f, s2 = 0.f;
    for (int i = 0; i < 64; ++i) { s1 += lv[i] * lv[64 + i]; s2 += lv[128 + i] * lv[192 + i]; }
    float li = 0.8f - 0.6f * expf(-0.3f * (float)tid);
    float* mf = (float*)(p.ws + WS_MISC);
    mf[tid] = expf(s1) - expf(s2) + li;
    mf[2 + tid] = li;
  }
  if (tid >= 8 && tid < 16) ((unsigned*)(p.ws + WS_MISC))[tid] = 0u;
}

DI void lora_item(const P& p, int i) {
  u16* LW = (u16*)(p.ws + WS_LORA);
  const int tid = otid();
#pragma unroll
  for (int q = 0; q < 4; ++q) {
    const int e = i * 2048 + q * NTHR + tid;
    float v;
    if (e < 131072) {
      const int e1 = e & 65535, r = e1 & 63, c = (e1 >> 6) & 255, ld = e1 >> 14;
      const float* src = e < 65536 ? p.w2 : p.a2;
      v = src[((size_t)ld * 64 + r) * 256 + c];
    } else {
      const int e1 = e - 131072, r = e1 & 127, c = (e1 >> 7) & 255, l_ = e1 >> 15;
      v = p.g2[((size_t)l_ * 128 + r) * 256 + c];
    }
    LW[e] = f2bf(v);
  }
}

DI void prep_phase(const P& p, int l) {
  const int nconv = 2816 + 1408 + 832 + 256;
  const int total = nconv + (l == 0 ? 289 + 96 : 0);
  for (int it = obid(); it < total; it += gridDim.x) {
    if (it < 2816) {
      int s = it / 1408, r = it % 1408;
      tr_tile(p.ffn_w_in + (size_t)(l * 2 + s) * 1024 * 5632, 5632, 1024, (u16*)(p.ws + WS_WIN) + (size_t)s * 5632 * 1024, r / 88, r % 88, 1);
    } else if (it < 2816 + 1408) {
      int q = it - 2816; int s = q / 704, r = q % 704;
      tr_tile(p.ffn_w_out + (size_t)(l * 2 + s) * 2816 * 1024, 1024, 2816, (u16*)(p.ws + WS_WOUT) + (size_t)s * 1024 * 2816, r / 16, r % 16, 0);
    } else if (it < 2816 + 1408 + 832) {
      int r = it - 4224;
      tr_tile(p.mix_w_in + (size_t)l * 1024 * 3200, 3200, 1024, (u16*)(p.ws + WS_MIN), r / 52, r % 52, 2);
    } else if (it < nconv) {
      int r = it - 5056;
      tr_tile(p.mix_w_out + (size_t)l * 1024 * 1024, 1024, 1024, (u16*)(p.ws + WS_MOUT), r / 16, r % 16, 0);
    } else if (it < nconv + 288) {
      mod_item(p, it - nconv);
    } else if (it == nconv + 288) {
      misc_item(p);
    } else {
      lora_item(p, it - nconv - 289);
    }
  }
}

DI void norm_phase(const P& p, int l, int gi, int si, bool first, int rows, int nslab = 0, bool ctxin = false) {
  const int lane = otid() & 63, w = otid() >> 6;
  const float* modb = (const float*)(p.ws + WS_MOD);
  u16* H = (u16*)(p.ws + WS_H);
  const float* g = p.norm_g + (size_t)(l * 3 + gi) * 1024;
  const int nw = (int)gridDim.x * 8, wid = obid() * 8 + w;
  const int per = nw >> 3;
  const bool grouped = (nw & 7) == 0 && per > 0 && (2048 % per) == 0;
  const int grp = grouped ? wid / per : 0, sub = grouped ? wid - grp * per : 0;
  const int nx = grouped ? 2048 / per : 0;
  const int nsteps = grouped ? nx + ((rows > TX) ? (TCX + nw - 1) / nw : 0) : (rows + nw - 1) / nw;
  int cur_m = -1;
  f32x4 A[4], B[4];
  for (int st = 0; st < nsteps; ++st) {
    int row;
    if (!grouped) { row = st * nw + wid; if (row >= rows) break; }
    else if (st < nx) row = grp * 2048 + st * per + sub;
    else { row = TX + (st - nx) * nw + wid; if (row >= rows) break; }
    const int mrow = row < TX ? (row >> 11) : 8;
    if (mrow != cur_m) {
      const float* md = modb + (size_t)(l * 9 + mrow) * 9216;
#pragma unroll
      for (int c = 0; c < 4; ++c) {
        const int k = (c >> 1) * 512 + lane * 8 + (c & 1) * 4;
        const f32x4 g4 = *(const f32x4*)&g[k], sh = *(const f32x4*)&md[si * 1024 + k], sc = *(const f32x4*)&md[(si + 1) * 1024 + k];
        A[c] = g4 * (sc + 1.f); B[c] = sh;
      }
      cur_m = mrow;
    }
    const bool fin = first || (ctxin && row >= TX);
    const float* src = fin ? (row < TX ? p.x + (size_t)row * D : p.ctx + (size_t)(row - TX) * D) : xrow(p, row);
    f32x4 v[4];
    const bool addsl = nslab > 0 && row >= TX;
#pragma unroll
    for (int c = 0; c < 4; ++c) v[c] = *(const f32x4*)&src[(c >> 1) * 512 + lane * 8 + (c & 1) * 4];
    if (addsl) {
      const u16* sl = (const u16*)(p.ws + WS_SLAB) + (size_t)(row - TX) * D;
      for (int q = 0; q < nslab; ++q) {
#pragma unroll
        for (int c2 = 0; c2 < 2; ++c2) {
          const uint4 a = *(const uint4*)&sl[(size_t)q * TCX * D + c2 * 512 + lane * 8];
          v[2 * c2] += (f32x4){__uint_as_float(a.x << 16), __uint_as_float(a.x & 0xffff0000u), __uint_as_float(a.y << 16), __uint_as_float(a.y & 0xffff0000u)};
          v[2 * c2 + 1] += (f32x4){__uint_as_float(a.z << 16), __uint_as_float(a.z & 0xffff0000u), __uint_as_float(a.w << 16), __uint_as_float(a.w & 0xffff0000u)};
        }
      }
    }
    float ss = 0.f;
#pragma unroll
    for (int c = 0; c < 4; ++c) ss += v[c][0] * v[c][0] + v[c][1] * v[c][1] + v[c][2] * v[c][2] + v[c][3] * v[c][3];
    ss = wave_sum(ss);
    const float rstd = rsqrtf(ss * (1.f / 1024.f) + 1e-6f);
    float* xd = xrow(p, row);
#pragma unroll
    for (int c2 = 0; c2 < 2; ++c2) {
      const f32x4 ha = v[2 * c2] * rstd * A[2 * c2] + B[2 * c2], hb = v[2 * c2 + 1] * rstd * A[2 * c2 + 1] + B[2 * c2 + 1];
      *(uint4*)&H[(size_t)row * 1024 + c2 * 512 + lane * 8] = make_uint4(pack2(ha[0], ha[1]), pack2(ha[2], ha[3]), pack2(hb[0], hb[1]), pack2(hb[2], hb[3]));
      if (addsl) { *(f32x4*)&xd[c2 * 512 + lane * 8] = v[2 * c2]; *(f32x4*)&xd[c2 * 512 + lane * 8 + 4] = v[2 * c2 + 1]; }
    }
  }
}

DI void final_phase(const P& p) {
  const int lane = otid() & 63, w = otid() >> 6;
  float4 gq[4];
#pragma unroll
  for (int c = 0; c < 4; ++c) gq[c] = ((const float4*)p.final_g)[c * 64 + lane];
  for (int row = obid() * 8 + w; row < TX; row += gridDim.x * 8) {
    float* src = p.out + (size_t)row * D;
    float4 v[4];
    float ss = 0.f;
#pragma unroll
    for (int c = 0; c < 4; ++c) {
      v[c] = ((const float4*)src)[c * 64 + lane];
      ss += v[c].x * v[c].x + v[c].y * v[c].y + v[c].z * v[c].z + v[c].w * v[c].w;
    }
    ss = wave_sum(ss);
    const float rstd = rsqrtf(ss * (1.f / 1024.f) + 1e-6f);
#pragma unroll
    for (int c = 0; c < 4; ++c) {
      const float4 g4 = gq[c];
      float4 o = make_float4(v[c].x * rstd * g4.x, v[c].y * rstd * g4.y, v[c].z * rstd * g4.z, v[c].w * rstd * g4.w);
      ((float4*)src)[c * 64 + lane] = o;
    }
  }
}

#define LAS __attribute__((address_space(3)))
constexpr int BM = 256, BK = 64, HALF = 128, HTB = HALF * BK * 2;
DI int lds_byte(int r, int c) { const int st = (r >> 4) * 2 + (c >> 5), rr = r & 15, cc = c & 31, ob = rr * 64 + cc * 2; return st * 1024 + (ob ^ (((ob >> 9) & 1) << 5)); }
DI void stage_rc(int b, int& R, int& C) { const int st = b / 1024, sb = b % 1024, swz = sb ^ (((sb >> 9) & 1) << 5); R = (st >> 1) * 16 + swz / 64; C = (st & 1) * 32 + (swz % 64) / 2; }
DI int perm32(int rho) { const int n = rho >> 4, i = rho & 15; return 8 * (i >> 2) + 4 * n + (i & 3); }
struct Unit { int pm, pn, k0, nkt, q; };
struct Gemm { const u16* A; const u16* Bt; int M, N, K; };
struct StaticOrder {
  int nM, nN, nwg, G, c, nkt, S, ntail;
  DI void init(int M, int N, int K, int G_, int c_, int Mx, int S_) {
    nN = N / BM; G = G_; c = c_; nkt = K / BK; S = S_;
    nM = (S_ > 0 ? Mx : M) / BM; nwg = nM * nN;
    ntail = S_ > 0 ? ((M - Mx) / BM) * nN * S_ : 0;
  }
  DI bool next(int i, Unit& u) const {
    const long L = (long)i * G + c;
    if (L >= nwg + ntail) return false;
    if (L >= nwg) {
      const int r = (int)L - nwg, tt = r / S, q = r - tt * S, nkp = nkt >> 1;
      const int kp0 = (q * nkp) / S, kp1 = ((q + 1) * nkp) / S;
      u.pm = nM + tt / nN; u.pn = tt % nN; u.k0 = 2 * kp0; u.nkt = 2 * (kp1 - kp0); u.q = q;
      return true;
    }
    int wgid = (int)L; { const int q = nwg / 8, r = nwg % 8, xcd = wgid % 8, off = wgid / 8; wgid = (xcd < r ? xcd * (q + 1) : r * (q + 1) + (xcd - r) * q) + off; }
    const int nig = 8 * nN, gid = wgid / nig, fm = gid * 8, gsz = (nM - fm) < 8 ? (nM - fm) : 8;
    u.pm = fm + ((wgid % nig) % gsz); u.pn = (wgid % nig) / gsz; u.k0 = 0; u.nkt = nkt; u.q = 0; return true;
  }
};

struct EpiSwiglu {
  static constexpr bool PERM = true;
  u16* ACT;
  DI void operator()(const f32x4 (&acc)[2][2][4][2], const Unit& u, int wr, int wc, int fr, int fq) const {
    const int row0 = u.pm * BM + wr * 64 + fr, col0 = u.pn * 128 + wc * 32 + 8 * fq;
#pragma unroll
    for (int ai = 0; ai < 2; ++ai)
#pragma unroll
      for (int m = 0; m < 4; ++m) {
        const int row = row0 + ai * HALF + m * 16;
        float v[8];
#pragma unroll
        for (int n = 0; n < 2; ++n)
#pragma unroll
          for (int e = 0; e < 4; ++e) { const float gt = acc[ai][0][m][n][e], up = acc[ai][1][m][n][e]; v[n * 4 + e] = gt * sigm(gt) * up; }
        uint4 o; o.x = pack2(v[0], v[1]); o.y = pack2(v[2], v[3]); o.z = pack2(v[4], v[5]); o.w = pack2(v[6], v[7]);
        *(uint4*)&ACT[(size_t)row * DFF + col0] = o;
      }
  }
};
struct EpiResid {
  static constexpr bool PERM = false;
  float* out; unsigned char* ws; int l, gidx, half, tail; const float* xin;
  DI void operator()(const f32x4 (&acc)[2][2][4][2], const Unit& u, int wr, int wc, int fr, int fq) const {
    float* xc = (float*)(ws + WS_XC); const float* mod = (const float*)(ws + WS_MOD); float* slab = (float*)(ws + WS_SLAB);
    const float sc = half ? 0.5f : 1.f;
    const int brow = u.pm * BM;
    const int mrow = brow < TX ? (brow >> 11) : 8;
    const int col0 = u.pn * BM + wc * 32 + 4 * fq;
    const float* gate = mod + (size_t)(l * 9 + mrow) * 9216 + gidx * 1024 + col0;
    f32x4 gv[2][2];
#pragma unroll
    for (int bj = 0; bj < 2; ++bj)
#pragma unroll
      for (int n = 0; n < 2; ++n) gv[bj][n] = *(const f32x4*)(gate + bj * HALF + n * 16) * sc;
    if (tail && brow >= TX) {
      u16* sp0 = (u16*)slab + ((size_t)u.q * TCX + (size_t)(brow - TX + wr * 64 + fr)) * D + (col0 - 4 * fq);
      const bool od = fq & 1;
#pragma unroll
      for (int ai = 0; ai < 2; ++ai)
#pragma unroll
        for (int m = 0; m < 4; ++m)
#pragma unroll
          for (int bj = 0; bj < 2; ++bj) {
            const f32x4 d0 = gv[bj][0] * acc[ai][bj][m][0], d1 = gv[bj][1] * acc[ai][bj][m][1];
            const uint2 q0 = make_uint2(pack2(d0[0], d0[1]), pack2(d0[2], d0[3])), q1 = make_uint2(pack2(d1[0], d1[1]), pack2(d1[2], d1[3]));
            const uint2 snd = od ? q0 : q1;
            const uint2 rcv = make_uint2((unsigned)__shfl_xor((int)snd.x, 16), (unsigned)__shfl_xor((int)snd.y, 16));
            const uint4 o4 = od ? make_uint4(rcv.x, rcv.y, q1.x, q1.y) : make_uint4(q0.x, q0.y, rcv.x, rcv.y);
            *(uint4*)(sp0 + (size_t)(ai * HALF + m * 16) * D + bj * HALF + (od ? 16 + 4 * (fq - 1) : 4 * fq)) = o4;
          }
      return;
    }
#pragma unroll
    for (int ai = 0; ai < 2; ++ai) {
      f32x4 xv[4][2][2];
      float* xp0 = (brow < TX ? out + (size_t)(brow + ai * HALF + wr * 64 + fr) * D : xc + (size_t)(brow - TX + ai * HALF + wr * 64 + fr) * D) + col0;
      const float* rp0 = (brow < TX ? xin + (size_t)(brow + ai * HALF + wr * 64 + fr) * D : xc + (size_t)(brow - TX + ai * HALF + wr * 64 + fr) * D) + col0;
#pragma unroll
      for (int m = 0; m < 4; ++m)
#pragma unroll
        for (int bj = 0; bj < 2; ++bj)
#pragma unroll
          for (int n = 0; n < 2; ++n) xv[m][bj][n] = *(const f32x4*)(rp0 + (size_t)m * 16 * D + bj * HALF + n * 16);
#pragma unroll
      for (int m = 0; m < 4; ++m)
#pragma unroll
        for (int bj = 0; bj < 2; ++bj)
#pragma unroll
          for (int n = 0; n < 2; ++n) *(f32x4*)(xp0 + (size_t)m * 16 * D + bj * HALF + n * 16) = xv[m][bj][n] + gv[bj][n] * acc[ai][bj][m][n];
    }
  }
};
struct EpiMix {
  static constexpr bool PERM = false;
  unsigned char* ws;
  DI void operator()(const f32x4 (&acc)[2][2][4][2], const Unit& u, int wr, int wc, int fr, int fq) const {
    const float* rope = (const float*)(ws + WS_ROPE);
    const int brow = u.pm * BM, bcol = u.pn * BM;
    const bool isx = brow < TX;
    const int bb = isx ? (brow >> 11) : ((brow - TX) >> 8);
#pragma unroll
    for (int bj = 0; bj < 2; ++bj) {
      const int base32 = bcol + bj * HALF + wc * 32;
      if (base32 >= 3200) continue;
      if (base32 < 1664) {
        u16* dst; int ld, cb;
        if (base32 < 1152) { dst = (u16*)(ws + WS_FR); ld = 1152; cb = base32; }
        else { dst = (u16*)(ws + WS_FC); ld = 512; cb = base32 - 1152; }
#pragma unroll
        for (int ai = 0; ai < 2; ++ai)
#pragma unroll
          for (int m = 0; m < 4; ++m) {
            const int row = brow + ai * HALF + wr * 64 + m * 16 + fr;
            const uint2 q0 = make_uint2(pack2(acc[ai][bj][m][0][0], acc[ai][bj][m][0][1]), pack2(acc[ai][bj][m][0][2], acc[ai][bj][m][0][3]));
            const uint2 q1 = make_uint2(pack2(acc[ai][bj][m][1][0], acc[ai][bj][m][1][1]), pack2(acc[ai][bj][m][1][2], acc[ai][bj][m][1][3]));
            const bool od = fq & 1;
            const uint2 snd = od ? q0 : q1;
            const uint2 rcv = make_uint2((unsigned)__shfl_xor((int)snd.x, 16), (unsigned)__shfl_xor((int)snd.y, 16));
            const uint4 o4 = od ? make_uint4(rcv.x, rcv.y, q1.x, q1.y) : make_uint4(q0.x, q0.y, rcv.x, rcv.y);
            *(uint4*)&dst[(size_t)row * ld + cb + (od ? 16 + 4 * (fq - 1) : 4 * fq)] = o4;
          }
      } else if (base32 < 2688) {
        const bool isq = base32 < 2176;
        const int cb = isq ? base32 - 1664 : base32 - 2176;
        const int axis = (base32 >> 5) & 1;
        const float qs = isq ? 0.125f * 1.4426950408889634f : 1.f;
#pragma unroll
        for (int ai = 0; ai < 2; ++ai)
#pragma unroll
          for (int m = 0; m < 4; ++m) {
            const int row = brow + ai * HALF + wr * 64 + m * 16 + fr;
            f32x4 t1 = acc[ai][bj][m][0], t2 = acc[ai][bj][m][1];
            int keyidx;
            if (isx) {
              const int npos = row & 2047;
              const int ps = axis ? (npos & 63) : (npos >> 6);
              const f32x4 ca = *(const f32x4*)&rope[(ps * 16 + 4 * fq) * 2];
              const f32x4 cb4 = *(const f32x4*)&rope[(ps * 16 + 4 * fq) * 2 + 4];
              const f32x4 cs = {ca[0], ca[2], cb4[0], cb4[2]}, sn = {ca[1], ca[3], cb4[1], cb4[3]};
              const f32x4 o1 = t1 * cs - t2 * sn, o2 = t2 * cs + t1 * sn;
              t1 = o1; t2 = o2; keyidx = npos;
            } else keyidx = 2048 + ((row - TX) & 255);
            t1 = t1 * qs; t2 = t2 * qs;
            const uint2 q0 = make_uint2(pack2(t1[0], t1[1]), pack2(t1[2], t1[3]));
            const uint2 q1 = make_uint2(pack2(t2[0], t2[1]), pack2(t2[2], t2[3]));
            const bool od = fq & 1;
            const uint2 snd = od ? q0 : q1;
            const uint2 rcv = make_uint2((unsigned)__shfl_xor((int)snd.x, 16), (unsigned)__shfl_xor((int)snd.y, 16));
            const uint4 o4 = od ? make_uint4(rcv.x, rcv.y, q1.x, q1.y) : make_uint4(q0.x, q0.y, rcv.x, rcv.y);
            u16* dst = isq ? (u16*)(ws + WS_Q) + (size_t)row * 512 + cb
                           : (u16*)(ws + WS_KK) + ((size_t)bb * 2304 + keyidx) * 512 + cb;
            *(uint4*)(dst + (od ? 16 + 4 * (fq - 1) : 4 * fq)) = o4;
          }
      } else {
        u16* VT = (u16*)(ws + WS_VT);
        const int cb = base32 - 2688;
#pragma unroll
        for (int ai = 0; ai < 2; ++ai)
#pragma unroll
          for (int m = 0; m < 4; ++m) {
            const int rowb = brow + ai * HALF + wr * 64 + m * 16 + (fr & ~3);
            const int keyb = isx ? (rowb & 2047) : 2048 + ((rowb - TX) & 255);
            const bool od1 = fr & 1, od2 = (fr >> 1) & 1;
            unsigned own[8];
#pragma unroll
            for (int n = 0; n < 2; ++n)
#pragma unroll
              for (int e = 0; e < 4; ++e) own[n * 4 + e] = (unsigned)f2bf(acc[ai][bj][m][n][e]);
            unsigned pr[4];
#pragma unroll
            for (int i = 0; i < 4; ++i) {
              const unsigned snd = od1 ? own[i] : own[4 + i], kp = od1 ? own[4 + i] : own[i];
              const unsigned rc = (unsigned)__builtin_amdgcn_update_dpp(0, (int)snd, 0xB1, 0xF, 0xF, true);
              pr[i] = od1 ? (rc | (kp << 16)) : (kp | (rc << 16));
            }
#pragma unroll
            for (int j = 0; j < 2; ++j) {
              const unsigned snd = od2 ? pr[j] : pr[2 + j], kp = od2 ? pr[2 + j] : pr[j];
              const unsigned rc = (unsigned)__builtin_amdgcn_update_dpp(0, (int)snd, 0x4E, 0xF, 0xF, true);
              const uint2 o2 = od2 ? make_uint2(rc, kp) : make_uint2(kp, rc);
              const int cc = cb + (od1 ? 16 : 0) + 4 * fq + (od2 ? 2 : 0) + j;
              *(uint2*)&VT[((size_t)bb * 512 + cc) * 2304 + keyb] = o2;
            }
          }
      }
    }
  }
};

template <class Epi>
DI void gemm_phase(const Gemm g, const Epi& E, int Mx = 0, int S_ = 0) {
  LAS unsigned char* lds = (LAS unsigned char*)smem;
  StaticOrder S; S.init(g.M, g.N, g.K, (int)gridDim.x, (int)obid(), Mx, S_);
  const int tid = otid(), wid = __builtin_amdgcn_readfirstlane(tid >> 6), lane = tid & 63, wr = wid >> 2, wc = wid & 3, fr = lane & 15, fq = lane >> 4;
  const int K = g.K;
  unsigned voffA[2], voffB[2];
#pragma unroll
  for (int i = 0; i < 2; ++i) { int R, C; stage_rc(tid * 16 + i * 8192, R, C); const int Rb = Epi::PERM ? ((R & ~31) + perm32(R & 31)) : R;
    voffA[i] = (unsigned)(R * K + C) * 2u; voffB[i] = (unsigned)(Rb * K + C) * 2u; }
  const size_t kstep = (size_t)(BK * 2);
  const size_t hstep = (size_t)HALF * K * 2;
  const size_t tstep = 2 * hstep;
  const unsigned ldsw = (unsigned)wid * 1024u;
  const int aoff = lds_byte(wr * 64 + fr, fq * 8), boff = lds_byte(wc * 32 + fr, fq * 8);
#define PG8_SA(b, h) (((b) * 2 + (h)) * HTB)
#define PG8_SB(b, h) ((4 + (b) * 2 + (h)) * HTB)
#define PG8_STAGE(bufoff, gbase, voff) do { _Pragma("unroll") for (int _i = 0; _i < 2; ++_i) \
    __builtin_amdgcn_global_load_lds((const unsigned*)((const char*)(gbase) + (voff)[_i]), (LAS unsigned*)(lds + (bufoff) + ldsw + _i * 8192), 16, 0, 0); } while (0)
#define PG8_LDA(dst, b, h) do { _Pragma("unroll") for (int m = 0; m < 4; ++m) _Pragma("unroll") for (int k = 0; k < 2; ++k) dst[m][k] = *(const LAS bf16x8*)(lds + PG8_SA(b, h) + aoff + m * 2048 + k * 1024); } while (0)
#define PG8_LDB(dst, b, h) do { _Pragma("unroll") for (int n = 0; n < 2; ++n) _Pragma("unroll") for (int k = 0; k < 2; ++k) dst[n][k] = *(const LAS bf16x8*)(lds + PG8_SB(b, h) + boff + n * 2048 + k * 1024); } while (0)
#define PG8_MMA(ai, bj, At, Bt) do { __builtin_amdgcn_s_setprio(1); _Pragma("unroll") for (int m = 0; m < 4; ++m) _Pragma("unroll") for (int n = 0; n < 2; ++n) _Pragma("unroll") for (int k = 0; k < 2; ++k) \
    acc[ai][bj][m][n] = __builtin_amdgcn_mfma_f32_16x16x32_bf16(Bt[n][k], At[m][k], acc[ai][bj][m][n], 0, 0, 0); __builtin_amdgcn_s_setprio(0); } while (0)
#define PG8_WAIT_V(n) asm volatile("s_waitcnt vmcnt(" #n ")" ::: "memory")
#define PG8_WAIT_L(n) asm volatile("s_waitcnt lgkmcnt(" #n ")" ::: "memory")
#define PG8_BAR __builtin_amdgcn_s_barrier()
#define PG8_SCHED __builtin_amdgcn_sched_barrier(0)
  Unit cur, nxt; int ui = 0;
  if (!S.next(0, cur)) return;
  f32x4 acc[2][2][4][2];
#pragma unroll
  for (int a = 0; a < 2; ++a)
#pragma unroll
    for (int b = 0; b < 2; ++b)
#pragma unroll
      for (int m = 0; m < 4; ++m)
#pragma unroll
        for (int n = 0; n < 2; ++n) acc[a][b][m][n] = (f32x4){0.f, 0.f, 0.f, 0.f};
  bf16x8 At[4][2], B0[2][2], B1[2][2];
  const char* cA = (const char*)g.A + (size_t)cur.pm * tstep + (size_t)cur.k0 * kstep; const char* cB = (const char*)g.Bt + (size_t)cur.pn * tstep + (size_t)cur.k0 * kstep;
  PG8_STAGE(PG8_SB(0, 0), cB, voffB); PG8_STAGE(PG8_SA(0, 0), cA, voffA); PG8_STAGE(PG8_SB(0, 1), cB + hstep, voffB); PG8_STAGE(PG8_SA(0, 1), cA + hstep, voffA);
  if (wr == 1) PG8_BAR;
  PG8_WAIT_V(4); PG8_BAR;
  PG8_STAGE(PG8_SB(1, 0), cB + kstep, voffB); PG8_STAGE(PG8_SA(1, 0), cA + kstep, voffA); PG8_STAGE(PG8_SB(1, 1), cB + hstep + kstep, voffB);
  PG8_WAIT_V(6); PG8_BAR;
  for (;;) {
    const bool has_next = S.next(ui + 1, nxt);
    const char* nA = has_next ? (const char*)g.A + (size_t)nxt.pm * tstep + (size_t)nxt.k0 * kstep : cA; const char* nB = has_next ? (const char*)g.Bt + (size_t)nxt.pn * tstep + (size_t)nxt.k0 * kstep : cB;
    const int nt = cur.nkt;
    for (int t = 0; t < nt; t += 2) {
      const bool last = (t == nt - 2);
      const char* a1 = cA + (size_t)(t + 1) * kstep;
      const char* a2 = last ? nA : cA + (size_t)(t + 2) * kstep; const char* b2 = last ? nB : cB + (size_t)(t + 2) * kstep;
      const char* a3 = a2 + kstep; const char* b3 = b2 + kstep;
      PG8_LDB(B0, 0, 0); PG8_SCHED; PG8_LDA(At, 0, 0); PG8_STAGE(PG8_SA(1, 1), a1 + hstep, voffA);
      PG8_WAIT_L(8); PG8_BAR; PG8_WAIT_L(0); PG8_MMA(0, 0, At, B0); PG8_BAR; PG8_SCHED;
      PG8_LDB(B1, 0, 1); PG8_STAGE(PG8_SB(0, 0), b2, voffB);
      PG8_BAR; PG8_WAIT_L(0); PG8_MMA(0, 1, At, B1); PG8_BAR;
      PG8_LDA(At, 0, 1); PG8_STAGE(PG8_SA(0, 0), a2, voffA);
      PG8_BAR; PG8_WAIT_L(0); PG8_MMA(1, 0, At, B0); PG8_BAR; PG8_SCHED;
      PG8_STAGE(PG8_SB(0, 1), b2 + hstep, voffB);
      PG8_WAIT_V(6); PG8_BAR; PG8_MMA(1, 1, At, B1); PG8_BAR;
      PG8_LDB(B0, 1, 0); PG8_SCHED; PG8_LDA(At, 1, 0); PG8_STAGE(PG8_SA(0, 1), a2 + hstep, voffA);
      PG8_WAIT_L(8); PG8_BAR; PG8_WAIT_L(0); PG8_MMA(0, 0, At, B0); PG8_BAR; PG8_SCHED;
      PG8_LDB(B1, 1, 1); PG8_STAGE(PG8_SB(1, 0), b3, voffB);
      PG8_BAR; PG8_WAIT_L(0); PG8_MMA(0, 1, At, B1); PG8_BAR;
      PG8_LDA(At, 1, 1); PG8_STAGE(PG8_SA(1, 0), a3, voffA);
      PG8_BAR; PG8_WAIT_L(0); PG8_MMA(1, 0, At, B0); PG8_BAR; PG8_SCHED;
      PG8_STAGE(PG8_SB(1, 1), b3 + hstep, voffB);
      PG8_WAIT_V(6); PG8_BAR; PG8_MMA(1, 1, At, B1); PG8_BAR;
    }
    E(acc, cur, wr, wc, fr, fq);
    if (!has_next) break;
#pragma unroll
    for (int a = 0; a < 2; ++a)
#pragma unroll
      for (int b = 0; b < 2; ++b)
#pragma unroll
        for (int m = 0; m < 4; ++m)
#pragma unroll
          for (int n = 0; n < 2; ++n) acc[a][b][m][n] = (f32x4){0.f, 0.f, 0.f, 0.f};
    cur = nxt; cA = nA; cB = nB; ++ui;
  }
  PG8_WAIT_V(0);
  if (wr == 0) PG8_BAR;
  PG8_BAR;
#undef PG8_SA
#undef PG8_SB
#undef PG8_STAGE
#undef PG8_LDA
#undef PG8_LDB
#undef PG8_MMA
}


constexpr int FS_LD = 772;
constexpr int AB_LD = 392;
constexpr int PRM_OFF = 32 * FS_LD * 4 + 32 * AB_LD * 2;
DI float blo(unsigned u) { return __uint_as_float(u << 16); }
DI float bhi(unsigned u) { return __uint_as_float(u & 0xffff0000u); }
DI void rwkv_prep_item(const P& p, int l, int item) {
  float* fs = (float*)smem;
  u16* ab = (u16*)(smem + 32 * FS_LD * 4);
  const int tid = otid();
  const int t0 = item * 32;
  int L, n0;
  if (t0 < TX) { L = 2048; n0 = t0 & 2047; } else { L = 256; n0 = (t0 - TX) & 255; }
  const u16* FR = (const u16*)(p.ws + WS_FR);
  const float* mu0 = p.mu + (size_t)l * 2 * 1152;
  const float* mu1 = mu0 + 1152;
  {
    uint4 fu[9], pu[9], nu[9];
#pragma unroll
    for (int q = 0; q < 9; ++q) {
      const int idx = q * NTHR + tid;
      const int tk = idx / 144, ci = (idx - tk * 144) * 8;
      const int n = n0 + tk;
      const size_t row = (size_t)(t0 + tk);
      fu[q] = *(const uint4*)&FR[row * 1152 + ci];
      pu[q] = *(const uint4*)&FR[(row - (n > 0 ? 1 : 0)) * 1152 + ci];
      nu[q] = *(const uint4*)&FR[(row + (n < L - 1 ? 1 : 0)) * 1152 + ci];
    }
#pragma unroll
    for (int q = 0; q < 9; ++q) {
      const int idx = q * NTHR + tid;
      const int tk = idx / 144, ci = (idx - tk * 144) * 8;
      const int n = n0 + tk;
      const uint4 z4 = make_uint4(0u, 0u, 0u, 0u);
      const uint4 pq = n > 0 ? pu[q] : z4, nq = n < L - 1 ? nu[q] : z4;
      const unsigned fw[4] = {fu[q].x, fu[q].y, fu[q].z, fu[q].w}, pw_[4] = {pq.x, pq.y, pq.z, pq.w}, nw_[4] = {nq.x, nq.y, nq.z, nq.w};
      f32x4 v[2];
#pragma unroll
      for (int hlf = 0; hlf < 2; ++hlf) {
        const f32x4 m0 = *(const f32x4*)&mu0[ci + 4 * hlf], m1 = *(const f32x4*)&mu1[ci + 4 * hlf];
        const f32x4 ff = {blo(fw[2 * hlf]), bhi(fw[2 * hlf]), blo(fw[2 * hlf + 1]), bhi(fw[2 * hlf + 1])};
        const f32x4 pp = {blo(pw_[2 * hlf]), bhi(pw_[2 * hlf]), blo(pw_[2 * hlf + 1]), bhi(pw_[2 * hlf + 1])};
        const f32x4 nn = {blo(nw_[2 * hlf]), bhi(nw_[2 * hlf]), blo(nw_[2 * hlf + 1]), bhi(nw_[2 * hlf + 1])};
        v[hlf] = ff + m0 * (pp - ff) + m1 * (nn - ff);
      }
      if (ci < 768) { *(f32x4*)&fs[tk * FS_LD + ci] = v[0]; *(f32x4*)&fs[tk * FS_LD + ci + 4] = v[1]; }
      else {
        const bool isT = ci < 896, isS = ci >= 1024;
        const float sc = isT ? 2.f : 1.f;
#pragma unroll
        for (int hlf = 0; hlf < 2; ++hlf)
#pragma unroll
          for (int e = 0; e < 4; ++e) { const float y = sigm(sc * v[hlf][e]); v[hlf][e] = isT ? 2.f * y - 1.f : (isS ? y : v[hlf][e]); }
        *(uint4*)&ab[tk * AB_LD + (ci - 768)] = make_uint4(pack2(v[0][0], v[0][1]), pack2(v[0][2], v[0][3]), pack2(v[1][0], v[1][1]), pack2(v[1][2], v[1][3]));
      }
    }
  }
  __syncthreads();
  const int lane = tid & 63, w = tid >> 6, h = w & 3, mt = w >> 2, col = lane & 15, kc = lane >> 4;
  bf16x8 af_[12];
#pragma unroll
  for (int i = 0; i < 12; ++i) af_[i] = *(const bf16x8*)&ab[(mt * 16 + col) * AB_LD + i * 32 + kc * 8];
  const u16* LW = (const u16*)(p.ws + WS_LORA);
  const u16* W2T = LW + (size_t)(l * 2) * 256 * 64;
  const u16* A2T = LW + 65536 + (size_t)(l * 2) * 256 * 64;
  const u16* G2T = LW + 131072 + (size_t)l * 256 * 128;
  const int tk = mt * 16 + col;
  const float* fr_ = fs + tk * FS_LD;
  float rsq = 0.f;
#pragma unroll
  for (int nt = 0; nt < 4; ++nt) {
    const int c4 = h * 64 + nt * 16 + kc * 4;
    const float4 kv = *(const float4*)&fr_[256 + c4];
    const float4 ks4 = *(const float4*)&((const float*)(smem + PRM_OFF))[4 * 256 + c4];
    const float q0 = kv.x * ks4.x, q1 = kv.y * ks4.y, q2 = kv.z * ks4.z, q3 = kv.w * ks4.w;
    rsq += q0 * q0 + q1 * q1 + q2 * q2 + q3 * q3;
  }
  rsq += __shfl_xor(rsq, 16); rsq += __shfl_xor(rsq, 32);
  const float rs = rsqrtf(rsq + 1e-12f);
  float bsp = 0.f;
  u16* SC = (u16*)(p.ws + WS_SC);
  u16* Gp = (u16*)(p.ws + WS_G);
  u16* BON = (u16*)(p.ws + WS_BON);
  constexpr size_t AS = (size_t)T * 256;
  bf16x8 wq[2][12];
#define LOADW(buf, nt_) do { const int ca_ = h * 64 + ((nt_) >> 1) * 32 + (col >> 2) * 8 + ((nt_) & 1) * 4 + (col & 3);     \
    _Pragma("unroll") for (int ks = 0; ks < 2; ++ks) { \
      wq[buf][0 + ks] = *(const bf16x8*)&W2T[(size_t)ca_ * 64 + ks * 32 + kc * 8]; \
      wq[buf][2 + ks] = *(const bf16x8*)&W2T[(size_t)(256 + ca_) * 64 + ks * 32 + kc * 8]; \
      wq[buf][4 + ks] = *(const bf16x8*)&A2T[(size_t)ca_ * 64 + ks * 32 + kc * 8]; \
      wq[buf][6 + ks] = *(const bf16x8*)&A2T[(size_t)(256 + ca_) * 64 + ks * 32 + kc * 8]; } \
    _Pragma("unroll") for (int ks = 0; ks < 4; ++ks) wq[buf][8 + ks] = *(const bf16x8*)&G2T[(size_t)ca_ * 128 + ks * 32 + kc * 8]; } while (0)
  uint2 lo_[10];
  LOADW(0, 0);
#pragma unroll
  for (int nt = 0; nt < 4; ++nt) {
    if (nt + 1 < 4) LOADW((nt + 1) & 1, nt + 1);
    const int c4 = h * 64 + (nt >> 1) * 32 + kc * 8 + (nt & 1) * 4;
    f32x4 cwf = {0.f, 0.f, 0.f, 0.f}, cwb = cwf, caf = cwf, cab = cwf, cg = cwf;
#pragma unroll
    for (int ks = 0; ks < 2; ++ks) {
      cwf = __builtin_amdgcn_mfma_f32_16x16x32_bf16(wq[nt & 1][0 + ks], af_[0 + ks], cwf, 0, 0, 0);
      cwb = __builtin_amdgcn_mfma_f32_16x16x32_bf16(wq[nt & 1][2 + ks], af_[2 + ks], cwb, 0, 0, 0);
      caf = __builtin_amdgcn_mfma_f32_16x16x32_bf16(wq[nt & 1][4 + ks], af_[4 + ks], caf, 0, 0, 0);
      cab = __builtin_amdgcn_mfma_f32_16x16x32_bf16(wq[nt & 1][6 + ks], af_[6 + ks], cab, 0, 0, 0);
    }
#pragma unroll
    for (int ks = 0; ks < 4; ++ks) cg = __builtin_amdgcn_mfma_f32_16x16x32_bf16(wq[nt & 1][8 + ks], af_[8 + ks], cg, 0, 0, 0);
    const float* prm = (const float*)(smem + PRM_OFF);
    const f32x4 w0f = *(const f32x4*)&prm[0 * 256 + c4], w0b = *(const f32x4*)&prm[1 * 256 + c4];
    const f32x4 a0f = *(const f32x4*)&prm[2 * 256 + c4], a0b = *(const f32x4*)&prm[3 * 256 + c4];
    const f32x4 kks = *(const f32x4*)&prm[4 * 256 + c4], kas = *(const f32x4*)&prm[5 * 256 + c4], rkc = *(const f32x4*)&prm[6 * 256 + c4];
    const f32x4 r4 = *(const f32x4*)&fr_[c4], k4 = *(const f32x4*)&fr_[256 + c4], v4 = *(const f32x4*)&fr_[512 + c4];
    float o_r[4], o_v[4], o_a[4], o_w0[4], o_w1[4], o_k0[4], o_k1[4], o_b0[4], o_b1[4], o_g[4];
#pragma unroll
    for (int j = 0; j < 4; ++j) {
      const float r = r4[j], k = k4[j], v = v4[j];
      const float sd0 = 0.6065306597126334f * sigm(w0f[j] + cwf[j]);
      const float sd1 = 0.6065306597126334f * sigm(w0b[j] + cwb[j]);
      const float a0 = sigm(a0f[j] + caf[j]), a1 = sigm(a0b[j] + cab[j]);
      const float kkn = k * kks[j] * rs;
      const float k0 = k * (1.f + (a0 - 1.f) * kas[j]), k1 = k * (1.f + (a1 - 1.f) * kas[j]);
      bsp += r * (k0 + k1) * rkc[j];
      o_r[j] = r; o_v[j] = v; o_a[j] = -kkn; o_w0[j] = sd0; o_w1[j] = sd1; o_k0[j] = k0; o_k1[j] = k1; o_b0[j] = kkn * a0; o_b1[j] = kkn * a1; o_g[j] = cg[j];
    }
#define PK4(a_) make_uint2(pack2(a_[0], a_[1]), pack2(a_[2], a_[3]))
    if ((nt & 1) == 0) {
      lo_[0] = PK4(o_r); lo_[1] = PK4(o_v); lo_[2] = PK4(o_a); lo_[3] = PK4(o_w0); lo_[4] = PK4(o_w1);
      lo_[5] = PK4(o_k0); lo_[6] = PK4(o_k1); lo_[7] = PK4(o_b0); lo_[8] = PK4(o_b1); lo_[9] = PK4(o_g);
    } else {
      const size_t o = (size_t)(t0 + tk) * 256 + h * 64 + (nt >> 1) * 32 + kc * 8;
#define ST8(dst, a_, li) do { const uint2 hi_ = PK4(a_); *(uint4*)&(dst)[o] = make_uint4(lo_[li].x, lo_[li].y, hi_.x, hi_.y); } while (0)
      ST8(SC + 0 * AS, o_r, 0); ST8(SC + 1 * AS, o_v, 1); ST8(SC + 2 * AS, o_a, 2); ST8(SC + 3 * AS, o_w0, 3); ST8(SC + 4 * AS, o_w1, 4);
      ST8(SC + 5 * AS, o_k0, 5); ST8(SC + 6 * AS, o_k1, 6); ST8(SC + 7 * AS, o_b0, 7); ST8(SC + 8 * AS, o_b1, 8); ST8(Gp, o_g, 9);
#undef ST8
    }
  }
  bsp += __shfl_xor(bsp, 16); bsp += __shfl_xor(bsp, 32);
#pragma unroll
  for (int pp = 0; pp < 2; ++pp) {
    const int c8 = h * 64 + pp * 32 + kc * 8;
    const f32x4 va = *(const f32x4*)&fr_[512 + c8], vb = *(const f32x4*)&fr_[512 + c8 + 4];
    float oa[4], ob2[4];
#pragma unroll
    for (int j = 0; j < 4; ++j) { oa[j] = bsp * va[j]; ob2[j] = bsp * vb[j]; }
    const uint2 l2 = PK4(oa), h2 = PK4(ob2);
    *(uint4*)&BON[(size_t)(t0 + tk) * 256 + c8] = make_uint4(l2.x, l2.y, h2.x, h2.y);
  }
#undef PK4
#undef LOADW
  __syncthreads();
}

DI void conv_item(const P& p, int l, int item) {
  float* hb = (float*)smem;
  float* ob = hb + 62 * 256;
  const int tid = otid();
  const int t0 = item * 32;
  int L, n0;
  if (t0 < TX) { L = 2048; n0 = t0 & 2047; } else { L = 256; n0 = (t0 - TX) & 255; }
  const u16* FC = (const u16*)(p.ws + WS_FC);
  const int c = tid & 255, ph = tid >> 8;
  {
    uint4 vv_[4], gg_[4];
#pragma unroll
    for (int q = 0; q < 4; ++q) {
      const int idx = q * NTHR + tid;
      const int rr = idx >> 5, cq = (idx & 31) * 8;
      const int n = n0 + rr - 15;
      const bool ok = rr < 62 && n >= 0 && n < L;
      const size_t row = ok ? (size_t)(t0 + rr - 15) : (size_t)t0;
      vv_[q] = *(const uint4*)&FC[row * 512 + cq]; gg_[q] = *(const uint4*)&FC[row * 512 + 256 + cq];
    }
#pragma unroll
    for (int q = 0; q < 4; ++q) {
      const int idx = q * NTHR + tid;
      const int rr = idx >> 5, cq = (idx & 31) * 8;
      const int n = n0 + rr - 15;
      const bool ok = n >= 0 && n < L;
      const unsigned vw[4] = {vv_[q].x, vv_[q].y, vv_[q].z, vv_[q].w}, gw[4] = {gg_[q].x, gg_[q].y, gg_[q].z, gg_[q].w};
      f32x4 h0 = {0.f, 0.f, 0.f, 0.f}, h1 = h0;
      if (ok) {
        h0[0] = blo(vw[0]) * sigm(blo(gw[0])); h0[1] = bhi(vw[0]) * sigm(bhi(gw[0])); h0[2] = blo(vw[1]) * sigm(blo(gw[1])); h0[3] = bhi(vw[1]) * sigm(bhi(gw[1]));
        h1[0] = blo(vw[2]) * sigm(blo(gw[2])); h1[1] = bhi(vw[2]) * sigm(bhi(gw[2])); h1[2] = blo(vw[3]) * sigm(blo(gw[3])); h1[3] = bhi(vw[3]) * sigm(bhi(gw[3]));
      }
      if (rr < 62) { *(f32x4*)&hb[rr * 256 + cq] = h0; *(f32x4*)&hb[rr * 256 + cq + 4] = h1; }
    }
  }
  __syncthreads();
  {
    float wreg[31];
#pragma unroll
    for (int w = 0; w < 31; ++w) wreg[w] = p.dw_w[(size_t)(l * 31 + w) * 256 + c];
    const float bias = p.dw_b[l * 256 + c];
    for (int pp = 0; pp < 16; ++pp) {
      const int pos = ph * 16 + pp;
      float a = bias;
#pragma unroll
      for (int w = 0; w < 31; ++w) a += hb[(pos + w) * 256 + c] * wreg[w];
      ob[pos * 256 + c] = a;
    }
  }
  __syncthreads();
  {
    const int lane = tid & 63, w = tid >> 6;
    u16* CAT = (u16*)(p.ws + WS_H);
    const float4 g4 = *(const float4*)&p.cln_g[l * 256 + lane * 4];
    const float4 b4 = *(const float4*)&p.cln_b[l * 256 + lane * 4];
#pragma unroll
    for (int q = 0; q < 4; ++q) {
      const int pos = w * 4 + q;
      const float4 v = *(const float4*)&ob[pos * 256 + lane * 4];
      const float mu = wave_sum(v.x + v.y + v.z + v.w) * (1.f / 256.f);
      const float d0 = v.x - mu, d1 = v.y - mu, d2 = v.z - mu, d3 = v.w - mu;
      const float var = wave_sum(d0 * d0 + d1 * d1 + d2 * d2 + d3 * d3) * (1.f / 256.f);
      const float rs = rsqrtf(var + 1e-5f);
      float y0 = d0 * rs * g4.x + b4.x, y1 = d1 * rs * g4.y + b4.y, y2 = d2 * rs * g4.z + b4.z, y3 = d3 * rs * g4.w + b4.w;
      y0 *= sigm(y0); y1 *= sigm(y1); y2 *= sigm(y2); y3 *= sigm(y3);
      uint2 o; o.x = pack2(y0, y1); o.y = pack2(y2, y3);
      *(uint2*)&CAT[(size_t)(t0 + pos) * 1024 + 256 + lane * 4] = o;
    }
  }
  __syncthreads();
}

DI void prepconv_phase(const P& p, int l, int rep) {
  const int nprep = T / 32, nconv = (l == 0 ? T : TX) / 32;
  unsigned* ctr = (unsigned*)(p.ws + WS_MISC) + 12 + l + 2 * rep;
  int* slot = (int*)(smem + LDS_CTL);
  {
    float* prm = (float*)(smem + PRM_OFF);
    for (int i = otid(); i < 7 * 256; i += NTHR) {
      const int a = i >> 8, c = i & 255;
      prm[i] = a < 2 ? p.w0[(l * 2 + a) * 256 + c] : a < 4 ? p.a0[(l * 2 + (a - 2)) * 256 + c] : a == 4 ? p.kk[l * 256 + c] : a == 5 ? p.ka[l * 256 + c] : p.rk[l * 256 + c];
    }
    __syncthreads();
  }
  int it = obid();
  while (it < nprep + nconv) {
    unsigned nx = 0u;
    if (otid() == 0) nx = atomicAdd(ctr, 1u);
    if (it < nprep) { if (!(rep && MIXPROBE == 4)) rwkv_prep_item(p, l, it); }
    else { if (!(rep && MIXPROBE == 3)) conv_item(p, l, it - nprep); }
    if (otid() == 0) *slot = (int)(gridDim.x + nx);
    __syncthreads();
    it = *slot;
    __syncthreads();
  }
}

DI int scan_row(int b, int dir, int gs) {
  if (dir == 0) return gs < 256 ? TX + b * 256 + gs : b * 2048 + (gs - 256);
  return gs < 256 ? TX + b * 256 + (255 - gs) : b * 2048 + (2047 - (gs - 256));
}

DI float allred8(float v) {
  v += dppx<0xB1>(v); v += dppx<0x4E>(v); v += dppx<0x141>(v);
  return v;
}
typedef float f2 __attribute__((ext_vector_type(2)));
constexpr int SST = 320;
constexpr int SOFF_V = 16 * SST;
constexpr int SOFF_BK = SOFF_V + 512;
constexpr int SBUF = SOFF_BK + 64;
struct ScanStep { f2 a[4], w[4], r[4], b[4], k[4]; };
DI void scan_block(const P& p, int sb) {
  const int tid = otid();
  const int chain = sb >> 1, rh = sb & 1, b = chain >> 3, h = (chain >> 1) & 3, dir = chain & 1;
  float* stg = (float*)smem;
  float* ybuf = stg + 2 * SBUF;
  const u16* SC = (const u16*)(p.ws + WS_SC);
  constexpr size_t AS = (size_t)T * 256;
  const bool is_comp = tid < 256;
#define LO(u) __uint_as_float((u) << 16)
#define HI(u) __uint_as_float((u) & 0xffff0000u)
  if (is_comp) {
    const int lane = tid & 63, cw = tid >> 6, jg = lane & 7, rl = cw * 8 + (lane >> 3);
    f2 S[4];
#pragma unroll
    for (int i = 0; i < 4; ++i) S[i] = (f2){0.f, 0.f};
    __syncthreads();
    for (int ch = 0; ch < 144; ++ch) {
      const float* st = stg + (ch & 1) * SBUF;
      float* yb = (jg == 0) ? (ybuf + (ch & 1) * 512 + rl) : (ybuf + 1024 + tid);
#define SLD(R, s) do { const float* d_ = st + (s) * SST + jg * 8; \
      { const float4 x_ = *(const float4*)&d_[0], y_ = *(const float4*)&d_[4]; R.a[0] = (f2){x_.x, x_.y}; R.a[1] = (f2){x_.z, x_.w}; R.a[2] = (f2){y_.x, y_.y}; R.a[3] = (f2){y_.z, y_.w}; } \
      { const float4 x_ = *(const float4*)&d_[64], y_ = *(const float4*)&d_[68]; R.w[0] = (f2){x_.x, x_.y}; R.w[1] = (f2){x_.z, x_.w}; R.w[2] = (f2){y_.x, y_.y}; R.w[3] = (f2){y_.z, y_.w}; } \
      { const float4 x_ = *(const float4*)&d_[128], y_ = *(const float4*)&d_[132]; R.r[0] = (f2){x_.x, x_.y}; R.r[1] = (f2){x_.z, x_.w}; R.r[2] = (f2){y_.x, y_.y}; R.r[3] = (f2){y_.z, y_.w}; } \
      { const float4 x_ = *(const float4*)&d_[192], y_ = *(const float4*)&d_[196]; R.b[0] = (f2){x_.x, x_.y}; R.b[1] = (f2){x_.z, x_.w}; R.b[2] = (f2){y_.x, y_.y}; R.b[3] = (f2){y_.z, y_.w}; } \
      { const float4 x_ = *(const float4*)&d_[256], y_ = *(const float4*)&d_[260]; R.k[0] = (f2){x_.x, x_.y}; R.k[1] = (f2){x_.z, x_.w}; R.k[2] = (f2){y_.x, y_.y}; R.k[3] = (f2){y_.z, y_.w}; } } while (0)
      float vv[16]; float bk[32];
#pragma unroll
      for (int q = 0; q < 4; ++q) { const float4 x_ = *(const float4*)&st[SOFF_V + rl * 16 + q * 4]; vv[q * 4] = x_.x; vv[q * 4 + 1] = x_.y; vv[q * 4 + 2] = x_.z; vv[q * 4 + 3] = x_.w; }
#pragma unroll
      for (int q = 0; q < 8; ++q) { const float4 x_ = *(const float4*)&st[SOFF_BK + q * 4]; bk[q * 4] = x_.x; bk[q * 4 + 1] = x_.y; bk[q * 4 + 2] = x_.z; bk[q * 4 + 3] = x_.w; }
      ScanStep cur, nxt;
      SLD(cur, 0);
#pragma unroll
      for (int s = 0; s < 16; ++s) {
        if (s + 1 < 16) SLD(nxt, s + 1);
        __builtin_amdgcn_sched_barrier(0);
        f2 t = S[0] * cur.a[0]; t = S[1] * cur.a[1] + t; t = S[2] * cur.a[2] + t; t = S[3] * cur.a[3] + t;
        f2 u = S[0] * cur.r[0]; u = S[1] * cur.r[1] + u; u = S[2] * cur.r[2] + u; u = S[3] * cur.r[3] + u;
        float sa = t.x + t.y, yp = u.x + u.y;
        sa = allred8(sa);
        yp = allred8(yp);
        const float v = vv[s];
        const float y = yp + sa * bk[2 * s] + v * bk[2 * s + 1];
        const f2 sa2 = (f2){sa, sa}, v2 = (f2){v, v};
#pragma unroll
        for (int i = 0; i < 4; ++i) S[i] = S[i] * cur.w[i] + (sa2 * cur.b[i] + v2 * cur.k[i]);
        yb[s * 32] = y;
        if (s + 1 < 16) cur = nxt;
      }
#undef SLD
      __syncthreads();
    }
    __syncthreads();
  } else {
    const int t2 = tid - 256, s_ = t2 >> 4, q_ = t2 & 15;
    const u16* Rp = SC, *Vp = SC + AS, *Ap = SC + 2 * AS, *Wp = SC + (3 + dir) * AS, *Kp = SC + (5 + dir) * AS, *Bp = SC + (7 + dir) * AS;
    u16* Y = (u16*)(p.ws + WS_Y) + (size_t)dir * AS;
    const int choff = h * 64 + 4 * q_;
    uint2 prA, pvA, paA, pwA, pkA, pbA, prB, pvB, paB, pwB, pkB, pbB;
#define SCAN_ISSUE(X, ch) do { const size_t o_ = (size_t)scan_row(b, dir, (ch) * 16 + s_) * 256 + choff; \
    pr##X = *(const uint2*)&Rp[o_]; pv##X = *(const uint2*)&Vp[o_]; pa##X = *(const uint2*)&Ap[o_]; \
    pw##X = *(const uint2*)&Wp[o_]; pk##X = *(const uint2*)&Kp[o_]; pb##X = *(const uint2*)&Bp[o_]; } while (0)
#define SCAN_COMMIT(X, bufi) do { float* d0_ = stg + (bufi) * SBUF; float* d_ = d0_ + s_ * SST; \
    const float4 r4 = make_float4(LO(pr##X.x), HI(pr##X.x), LO(pr##X.y), HI(pr##X.y)); \
    const float4 w4 = make_float4(__expf(-LO(pw##X.x)), __expf(-HI(pw##X.x)), __expf(-LO(pw##X.y)), __expf(-HI(pw##X.y))); \
    const float4 k4 = make_float4(LO(pk##X.x), HI(pk##X.x), LO(pk##X.y), HI(pk##X.y)); \
    const float4 b4 = make_float4(LO(pb##X.x), HI(pb##X.x), LO(pb##X.y), HI(pb##X.y)); \
    *(float4*)&d_[4 * q_] = make_float4(LO(pa##X.x), HI(pa##X.x), LO(pa##X.y), HI(pa##X.y)); \
    *(float4*)&d_[64 + 4 * q_] = w4; \
    *(float4*)&d_[128 + 4 * q_] = make_float4(w4.x * r4.x, w4.y * r4.y, w4.z * r4.z, w4.w * r4.w); \
    *(float4*)&d_[192 + 4 * q_] = b4; \
    *(float4*)&d_[256 + 4 * q_] = k4; \
    if ((q_ >> 3) == rh) { float* dv_ = d0_ + SOFF_V + 4 * (q_ & 7) * 16 + s_; dv_[0] = LO(pv##X.x); dv_[16] = HI(pv##X.x); dv_[32] = LO(pv##X.y); dv_[48] = HI(pv##X.y); } \
    float br_ = b4.x * r4.x + b4.y * r4.y + b4.z * r4.z + b4.w * r4.w; \
    float kr_ = k4.x * r4.x + k4.y * r4.y + k4.z * r4.z + k4.w * r4.w; \
    br_ = allred16(br_); kr_ = allred16(kr_); \
    if (q_ == 0) *(float2*)&d0_[SOFF_BK + 2 * s_] = make_float2(br_, kr_); } while (0)
#define SCAN_YSTORE(ch) do { const float* yb_ = ybuf + ((ch) & 1) * 512; \
    const float2 yv_ = *(const float2*)&yb_[s_ * 32 + 2 * q_]; \
    const int row_ = scan_row(b, dir, (ch) * 16 + s_); \
    *(unsigned*)&Y[(size_t)row_ * 256 + h * 64 + rh * 32 + 2 * q_] = pack2(yv_.x, yv_.y); } while (0)
    SCAN_ISSUE(A, 0);
    SCAN_COMMIT(A, 0);
    SCAN_ISSUE(B, 1);
    __syncthreads();
    for (int ch = 0; ch < 144; ch += 2) {
      SCAN_COMMIT(B, 1);
      if (ch + 2 < 144) SCAN_ISSUE(A, ch + 2);
      if (ch > 0) SCAN_YSTORE(ch - 1);
      __syncthreads();
      if (ch + 2 < 144) SCAN_COMMIT(A, 0);
      if (ch + 3 < 144) SCAN_ISSUE(B, ch + 3);
      SCAN_YSTORE(ch);
      __syncthreads();
    }
    SCAN_YSTORE(143);
    __syncthreads();
#undef SCAN_ISSUE
#undef SCAN_COMMIT
#undef SCAN_YSTORE
  }
}

#define MFMA32(a, b, c) __builtin_amdgcn_mfma_f32_32x32x16_bf16((a), (b), (c), 0, 0, 0)
constexpr int ATT_BUF = 36864;
DI void attn_item(const P& p, int l, int item) {
  const int tid = otid(), lane = tid & 63, wave = tid >> 6, m = wave >> 2, qw = wave & 3, r = lane & 31, hh = lane >> 5;
  int qrow0, b, h, key0, nk;
  if (item < 512) { b = item >> 6; h = (item >> 4) & 3; qrow0 = b * 2048 + (item & 15) * 128; key0 = 0; nk = 2304; }
  else { const int it = item - 512; b = it >> 3; h = (it >> 1) & 3; qrow0 = TX + b * 256 + (it & 1) * 128; key0 = 2048; nk = 256; }
  const u16* Q = (const u16*)(p.ws + WS_Q);
  const u16* KK = (const u16*)(p.ws + WS_KK) + ((size_t)b * 2304 + key0) * 512 + h * 128;
  const u16* VT = (const u16*)(p.ws + WS_VT) + ((size_t)(b * 4 + h) * 128) * 2304 + key0;
  bf16x8 qf[4];
  {
    const u16* qp = Q + (size_t)(qrow0 + qw * 32 + r) * 512 + h * 128 + m * 64 + hh * 8;
#pragma unroll
    for (int ks = 0; ks < 4; ++ks) qf[ks] = *(const bf16x8*)&qp[ks * 16];
  }
  uint4 g0 = make_uint4(0u, 0u, 0u, 0u), g1 = g0, g2 = g0, g3 = g0;
  const int ck0 = tid, ck1 = tid + 512;
  const int kdst0 = (ck0 >> 9) * 9216 + ((ck0 >> 3) & 63) * 144 + (ck0 & 7) * 16;
  const int kdst1 = (ck1 >> 9) * 9216 + ((ck1 >> 3) & 63) * 144 + (ck1 & 7) * 16;
  const size_t ksrc0 = (size_t)((ck0 >> 3) & 63) * 512 + (ck0 >> 9) * 64 + (ck0 & 7) * 8;
  const size_t ksrc1 = (size_t)((ck1 >> 3) & 63) * 512 + (ck1 >> 9) * 64 + (ck1 & 7) * 8;
  const int vdst0 = 18432 + (ck0 >> 3) * 144 + (ck0 & 7) * 16;
  const int vdst1 = 18432 + (ck1 >> 3) * 144 + (ck1 & 7) * 16;
  const size_t vsrc0 = (size_t)(ck0 >> 3) * 2304 + (ck0 & 7) * 8;
  const size_t vsrc1 = (size_t)(ck1 >> 3) * 2304 + (ck1 & 7) * 8;
#define ATT_LOAD(t) do { const u16* kp_ = KK + (size_t)(t) * 64 * 512; const u16* vp_ = VT + (t) * 64; \
    g0 = *(const uint4*)&kp_[ksrc0]; g1 = *(const uint4*)&kp_[ksrc1]; \
    g2 = *(const uint4*)&vp_[vsrc0]; g3 = *(const uint4*)&vp_[vsrc1]; } while (0)
#define ATT_STORE(bi) do { unsigned char* bb_ = smem + (bi) * ATT_BUF; \
    *(uint4*)(bb_ + kdst0) = g0; *(uint4*)(bb_ + kdst1) = g1; \
    *(uint4*)(bb_ + vdst0) = g2; *(uint4*)(bb_ + vdst1) = g3; } while (0)
#define ATT_QK(kb) do { _Pragma("unroll") for (int ks = 0; ks < 4; ++ks) { \
      const bf16x8 a0_ = *(const bf16x8*)((kb) + r * 144 + ks * 32 + hh * 16); \
      const bf16x8 a1_ = *(const bf16x8*)((kb) + (32 + r) * 144 + ks * 32 + hh * 16); \
      s0 = MFMA32(a0_, qf[ks], s0); s1 = MFMA32(a1_, qf[ks], s1); } } while (0)
#define ATT_PV1(vb, kt, s, PF) do { _Pragma("unroll") for (int nt = 0; nt < 4; ++nt) { \
        const unsigned char* vp_ = (vb) + (nt * 32 + r) * 144 + ((kt) * 32 + 16 * (s) + 4 * hh) * 2; \
        const s16x4 lo_ = *(const s16x4*)vp_; const s16x4 hi_ = *(const s16x4*)(vp_ + 16); \
        const bf16x8 vf_ = __builtin_shufflevector(lo_, hi_, 0, 1, 2, 3, 4, 5, 6, 7); \
        o[nt] = MFMA32(vf_, PF, o[nt]); } } while (0)
#define ATT_PV(vb) do { ATT_PV1(vb, 0, 0, pf0); ATT_PV1(vb, 0, 1, pf1); ATT_PV1(vb, 1, 0, pf2); ATT_PV1(vb, 1, 1, pf3); } while (0)
  const int ntile = nk / 64;
  ATT_LOAD(0);
  ATT_STORE(0);
  __syncthreads();
  float mrun;
  {
    f32x16 s0, s1;
#pragma unroll
    for (int j = 0; j < 16; ++j) { s0[j] = 0.f; s1[j] = 0.f; }
    const unsigned char* kb = smem + m * 9216;
    ATT_QK(kb);
    float mx = s0[0];
#pragma unroll
    for (int j = 1; j < 16; ++j) mx = fmaxf(mx, s0[j]);
#pragma unroll
    for (int j = 0; j < 16; ++j) mx = fmaxf(mx, s1[j]);
    mrun = fmaxf(mx, __shfl_xor(mx, 32));
  }
  f32x16 o[4];
#pragma unroll
  for (int i = 0; i < 4; ++i)
#pragma unroll
    for (int j = 0; j < 16; ++j) o[i][j] = 0.f;
  float lrun = 0.f;
  bf16x8 pf0, pf1, pf2, pf3;
#pragma unroll
  for (int j = 0; j < 8; ++j) { pf0[j] = 0; pf1[j] = 0; pf2[j] = 0; pf3[j] = 0; }
  for (int t = 0; t <= ntile; ++t) {
    if (t + 1 < ntile) ATT_LOAD(t + 1);
    if (m == 1 && t > 0) { const unsigned char* vb = smem + ((t - 1) % 3) * ATT_BUF + 18432; ATT_PV(vb); }
    if (t < ntile) {
      const unsigned char* kb = smem + (t % 3) * ATT_BUF + m * 9216;
      f32x16 s0, s1;
      const float nm = -mrun;
#pragma unroll
      for (int j = 0; j < 16; ++j) { s0[j] = nm; s1[j] = nm; }
      ATT_QK(kb);
      float mx = s0[0];
#pragma unroll
      for (int j = 1; j < 16; ++j) mx = fmaxf(mx, s0[j]);
#pragma unroll
      for (int j = 0; j < 16; ++j) mx = fmaxf(mx, s1[j]);
      if (__builtin_amdgcn_ballot_w64(mx > 8.f) != 0ull) {
        const float mo = fmaxf(mx, __shfl_xor(mx, 32));
        const float delta = fmaxf(mo, 0.f);
        const float alpha = __builtin_amdgcn_exp2f(-delta);
        mrun += delta; lrun *= alpha;
#pragma unroll
        for (int i = 0; i < 4; ++i)
#pragma unroll
          for (int j = 0; j < 16; ++j) o[i][j] *= alpha;
#pragma unroll
        for (int j = 0; j < 16; ++j) { s0[j] -= delta; s1[j] -= delta; }
      }
      float ls = 0.f;
#pragma unroll
      for (int j = 0; j < 16; ++j) { s0[j] = __builtin_amdgcn_exp2f(s0[j]); ls += s0[j]; }
#pragma unroll
      for (int j = 0; j < 16; ++j) { s1[j] = __builtin_amdgcn_exp2f(s1[j]); ls += s1[j]; }
      lrun += ls;
#pragma unroll
      for (int j = 0; j < 8; ++j) { pf0[j] = (short)f2bf(s0[j]); pf1[j] = (short)f2bf(s0[8 + j]); pf2[j] = (short)f2bf(s1[j]); pf3[j] = (short)f2bf(s1[8 + j]); }
    }
    if (m == 0 && t < ntile) { const unsigned char* vb = smem + (t % 3) * ATT_BUF + 18432; ATT_PV(vb); }
    if (t + 1 < ntile) ATT_STORE((t + 1) % 3);
    __syncthreads();
  }
  const float lt = lrun + __shfl_xor(lrun, 32);
  const float inv = 1.f / lt;
  float* ob = (float*)smem;
  if (m == 1) {
#pragma unroll
    for (int nt = 0; nt < 4; ++nt)
#pragma unroll
      for (int j = 0; j < 16; ++j) ob[((qw * 4 + nt) * 16 + j) * 64 + lane] = o[nt][j] * inv;
  }
  __syncthreads();
  if (m == 0) {
    const float* mf = (const float*)(p.ws + WS_MISC);
    const float lamv = mf[l], li = mf[2 + l];
    float ss = 0.f;
#pragma unroll
    for (int nt = 0; nt < 4; ++nt)
#pragma unroll
      for (int j = 0; j < 16; ++j) {
        const float dv = o[nt][j] * inv - lamv * ob[((qw * 4 + nt) * 16 + j) * 64 + lane];
        o[nt][j] = dv;
        ss += dv * dv;
      }
    ss += __shfl_xor(ss, 32);
    const float rs = rsqrtf(ss * (1.f / 128.f) + 1e-5f) * (1.f - li);
    u16* CAT = (u16*)(p.ws + WS_H) + (size_t)(qrow0 + qw * 32 + r) * 1024 + 512 + h * 128;
    const float* gp = p.dng + l * 128;
#pragma unroll
    for (int nt = 0; nt < 4; ++nt) {
      uint2 ch[4];
#pragma unroll
      for (int g = 0; g < 4; ++g) {
        const int vd = nt * 32 + 8 * g + 4 * hh;
        const float4 g4 = *(const float4*)&gp[vd];
        ch[g].x = pack2(o[nt][4 * g + 0] * rs * g4.x, o[nt][4 * g + 1] * rs * g4.y);
        ch[g].y = pack2(o[nt][4 * g + 2] * rs * g4.z, o[nt][4 * g + 3] * rs * g4.w);
      }
#pragma unroll
      for (int q = 0; q < 2; ++q) {
        const uint2 snd = hh ? ch[2 * q] : ch[2 * q + 1];
        const uint2 rcv = make_uint2((unsigned)__shfl_xor((int)snd.x, 32), (unsigned)__shfl_xor((int)snd.y, 32));
        const uint4 o4 = hh ? make_uint4(rcv.x, rcv.y, ch[2 * q + 1].x, ch[2 * q + 1].y) : make_uint4(ch[2 * q].x, ch[2 * q].y, rcv.x, rcv.y);
        *(uint4*)&CAT[nt * 32 + 16 * q + 8 * hh] = o4;
      }
    }
  }
  __syncthreads();
#undef ATT_LOAD
#undef ATT_STORE
#undef ATT_QK
#undef ATT_PV
#undef ATT_PV1
}

DI void mixer_phase(const P& p, int l, int rep) {
  if (!(rep && MIXPROBE == 1)) for (int sb = obid(); sb < 128; sb += gridDim.x) scan_block(p, sb);
  if (rep && MIXPROBE == 2) return;
  const int nitems = l == 0 ? 576 : 512;
  unsigned* ctr = (unsigned*)(p.ws + WS_MISC) + 8 + l + 2 * rep;
  int* slot = (int*)(smem + LDS_CTL);
  const int nstat = (int)gridDim.x > 128 ? (int)gridDim.x - 128 : 0;
  int it;
  if (obid() >= 128) it = obid() - 128;
  else {
    if (otid() == 0) *slot = nstat + (int)atomicAdd(ctr, 1u);
    __syncthreads();
    it = *slot;
    __syncthreads();
  }
  while (it < nitems) {
    unsigned nx = 0u;
    if (otid() == 0) nx = atomicAdd(ctr, 1u);
    attn_item(p, l, it);
    if (otid() == 0) *slot = nstat + (int)nx;
    __syncthreads();
    it = *slot;
    __syncthreads();
  }
}

DI void finish_phase(const P& p, int l, int rows) {
  const int lane = otid() & 63, w = otid() >> 6;
  const u16* Y = (const u16*)(p.ws + WS_Y);
  const u16* Gp = (const u16*)(p.ws + WS_G);
  const u16* BON = (const u16*)(p.ws + WS_BON);
  u16* CAT = (u16*)(p.ws + WS_H);
  constexpr size_t AS = (size_t)T * 256;
  const float4 g4 = *(const float4*)&p.ln_g[l * 256 + lane * 4];
  const float4 b4 = *(const float4*)&p.ln_b[l * 256 + lane * 4];
  for (int row = obid() * 8 + w; row < rows; row += gridDim.x * 8) {
    const size_t o = (size_t)row * 256 + lane * 4;
    const uint2 yf = *(const uint2*)&Y[o], yb = *(const uint2*)&Y[AS + o];
    const uint2 gg = *(const uint2*)&Gp[o], bo = *(const uint2*)&BON[o];
    float y0 = LO(yf.x) + LO(yb.x), y1 = HI(yf.x) + HI(yb.x), y2 = LO(yf.y) + LO(yb.y), y3 = HI(yf.y) + HI(yb.y);
    float s = y0 + y1 + y2 + y3;
    s = allred16(s);
    const float mu = s * (1.f / 64.f);
    y0 -= mu; y1 -= mu; y2 -= mu; y3 -= mu;
    float vs = y0 * y0 + y1 * y1 + y2 * y2 + y3 * y3;
    vs = allred16(vs);
    const float rs = rsqrtf(vs * (1.f / 64.f) + 64e-5f);
    const float o0 = (y0 * rs * g4.x + b4.x + LO(bo.x)) * LO(gg.x);
    const float o1 = (y1 * rs * g4.y + b4.y + HI(bo.x)) * HI(gg.x);
    const float o2 = (y2 * rs * g4.z + b4.z + LO(bo.y)) * LO(gg.y);
    const float o3 = (y3 * rs * g4.w + b4.w + HI(bo.y)) * HI(gg.y);
    uint2 ov; ov.x = pack2(o0, o1); ov.y = pack2(o2, o3);
    *(uint2*)&CAT[(size_t)row * 1024 + lane * 4] = ov;
  }
}


#define XB_TMO      128
#define XB_XCNT(j)  (256  + 64 * (j))
#define XB_XSUB(j)  (1280 + 64 * (j))
#define XB_XGEN(j)  (2304 + 64 * (j))
#define XB_TOP      3328
#define XB_TOPGEN   3392
#define XB_SPIN_CAP (1u << 20)
DI unsigned xb_ld(unsigned* p) { return __hip_atomic_load(p, __ATOMIC_RELAXED, __HIP_MEMORY_SCOPE_AGENT); }
DI unsigned xb_add(unsigned* p, unsigned v) { return __hip_atomic_fetch_add(p, v, __ATOMIC_RELAXED, __HIP_MEMORY_SCOPE_AGENT); }
DI unsigned xb_xcc_id() { return (unsigned)__builtin_amdgcn_s_getreg((3 << 11) | 20) & 0xFu; }
#define XB_SPIN(cond, bar) do { unsigned _sp = 0; while (cond) { __builtin_amdgcn_s_sleep(1); \
    if ((++_sp & 255u) == 0u) { if (xb_ld(&(bar)[XB_TMO])) break; if (_sp > XB_SPIN_CAP) { atomicAdd(&(bar)[XB_TMO], 1u); break; } } } } while (0)
struct XcdBarrier { unsigned* bar; unsigned x; volatile LAS unsigned* st; };
DI XcdBarrier xcd_barrier_post(unsigned* bar, volatile LAS unsigned* st) {
  XcdBarrier b; b.bar = bar; b.x = xb_xcc_id(); b.st = st;
  if (threadIdx.x == 0) (void)xb_add(&bar[XB_XCNT(b.x)], 1u);
  return b;
}
DI void xcd_barrier_complete(unsigned* bar, unsigned x, unsigned& nloc, unsigned& nx) {
  const unsigned G = gridDim.x * gridDim.y * gridDim.z;
  unsigned sum, cnt, mine, sp = 0u;
  for (;;) {
    sum = 0u; cnt = 0u; mine = 0u;
#pragma unroll
    for (unsigned j = 0; j < 16; ++j) { const unsigned c = xb_ld(&bar[XB_XCNT(j)]); sum += c; cnt += (c > 0u) ? 1u : 0u; mine = (j == x) ? c : mine; }
    if (sum == G) break;
    __builtin_amdgcn_s_sleep(1);
    if ((++sp & 255u) == 0u) { if (xb_ld(&bar[XB_TMO])) break; if (sp > XB_SPIN_CAP) { atomicAdd(&bar[XB_TMO], 1u); break; } }
  }
  nloc = mine > 0u ? mine : 1u; nx = cnt > 0u ? cnt : 1u;
}
DI void xcd_barrier(const XcdBarrier& b) {
  asm volatile("s_waitcnt vmcnt(0)" ::: "memory");
  __syncthreads();
  if (threadIdx.x == 0) {
    unsigned* bar = b.bar;
    __builtin_amdgcn_s_waitcnt(0);
    unsigned nloc = b.st[0], nx = b.st[1];
    if (nloc == 0u) { xcd_barrier_complete(bar, b.x, nloc, nx); b.st[0] = nloc; b.st[1] = nx; }
    const unsigned old = xb_add(&bar[XB_XSUB(b.x)], 1u);
    const unsigned gen = old / nloc;
    if (old + 1u == (gen + 1u) * nloc) {
      __builtin_amdgcn_fence(__ATOMIC_RELEASE, "agent");
      asm volatile("s_waitcnt vmcnt(0)" ::: "memory");
      const unsigned og = xb_add(&bar[XB_TOP], 1u);
      const unsigned tg = og / nx;
      if (og + 1u == (tg + 1u) * nx) xb_add(&bar[XB_TOPGEN], 1u);
      else XB_SPIN(xb_ld(&bar[XB_TOPGEN]) == tg, bar);
      __builtin_amdgcn_fence(__ATOMIC_ACQUIRE, "agent");
      xb_add(&bar[XB_XGEN(b.x)], 1u);
      asm volatile("s_waitcnt vmcnt(0)" ::: "memory");
    } else {
      XB_SPIN(xb_ld(&bar[XB_XGEN(b.x)]) == gen, bar);
      __builtin_amdgcn_fence(__ATOMIC_ACQUIRE, "agent");
      asm volatile("s_waitcnt vmcnt(0)" ::: "memory");
    }
  }
  __syncthreads();
}

constexpr int NPHASE = 26;
#ifndef REPMASK
#define REPMASK 0
#endif
#ifndef SYNCX
#define SYNCX 0
#endif
__global__ void __launch_bounds__(NTHR) mega(P p) {
  cg::grid_group grid = cg::this_grid();
  if (p.ph_hi > 1000) grid.sync();
  volatile LAS unsigned* stw = (volatile LAS unsigned*)((LAS unsigned char*)smem + LDS_CTL + 16);
  if (threadIdx.x < 4) stw[threadIdx.x] = 0u;
  __syncthreads();
  const XcdBarrier xb = xcd_barrier_post((unsigned*)(p.ws + WS_BAR), stw);
#define GSYNC() xcd_barrier(xb)
  const u16* H = (const u16*)(p.ws + WS_H);
  const u16* ACT = (const u16*)(p.ws + WS_ACT);
  const u16* WIN = (const u16*)(p.ws + WS_WIN);
  const u16* WOUT = (const u16*)(p.ws + WS_WOUT);
  const u16* WMIN = (const u16*)(p.ws + WS_MIN);
  const u16* WMOUT = (const u16*)(p.ws + WS_MOUT);
  for (int ph = p.ph_lo; ph < p.ph_hi; ++ph) {
    if (ph == 0) {
      prep_phase(p, 0);
    } else if (ph == 25) {
      final_phase(p);
    } else {
      const int l = (ph - 1) / 12, s = (ph - 1) % 12;
      const int Mx = (l == 1) ? TX : T;
      float* xo = p.out;
      u16* ACTw = (u16*)(p.ws + WS_ACT);
      for (int rep = 0; rep < 1 + ((REPMASK >> s) & 1); ++rep) {
      switch (s) {
        case 0: if (rep == 0 && l == 1) prep_phase(p, 1); norm_phase(p, l, 0, 0, l == 0, T, (l == 1 && rep == 0) ? 8 : 0); break;
        case 1: gemm_phase(Gemm{H, WIN, T, 5632, 1024}, EpiSwiglu{ACTw}); break;
        case 2: gemm_phase(Gemm{ACT, WOUT, T, 1024, 2816}, EpiResid{xo, p.ws, l, 2, 1, 1, l == 0 ? p.x : (const float*)xo}, TX, 8); break;
        case 3: norm_phase(p, l, 1, 3, false, T, rep == 0 ? 8 : 0, l == 0); break;
        case 4: gemm_phase(Gemm{H, WMIN, T, PINP, 1024}, EpiMix{p.ws}); break;
        case 5: prepconv_phase(p, l, rep); break;
        case 6: mixer_phase(p, l, rep); break;
        case 7: finish_phase(p, l, Mx); break;
        case 8: gemm_phase(Gemm{H, WMOUT, Mx, 1024, 1024}, EpiResid{xo, p.ws, l, 5, 0, l == 0, (const float*)xo}, TX, l == 0 ? 4 : 0); break;
        case 9: norm_phase(p, l, 2, 6, false, Mx, (l == 0 && rep == 0) ? 4 : 0); break;
        case 10: gemm_phase(Gemm{H, WIN + (size_t)5632 * 1024, Mx, 5632, 1024}, EpiSwiglu{ACTw}); break;
        case 11: gemm_phase(Gemm{ACT, WOUT + (size_t)1024 * 2816, Mx, 1024, 2816}, EpiResid{xo, p.ws, l, 8, 1, l == 0, (const float*)xo}, TX, l == 0 ? 8 : 0); break;
      }
      if (rep + 1 < 1 + ((REPMASK >> s) & 1)) GSYNC();
      }
    }
    if (ph + 1 < p.ph_hi) { GSYNC(); for (int q = 0; q < SYNCX; ++q) GSYNC(); }
  }
}

extern "C" void kernel_launch(void* const* d_in, const int* in_sizes, int n_in, void* d_out, int out_size, void* d_ws,
                              size_t ws_size, hipStream_t stream) {
  static int grid = 0;
  if (grid == 0) {
    if (n_in != 29 || ws_size < WS_END) {
      fprintf(stderr, "kernel_launch: need 29 inputs and %zu bytes of ws; got %d, %zu\n", (size_t)WS_END, n_in, ws_size);
      grid = -1; return;
    }
    int dev = 0, cus = 0, per_cu = 0;
    hipGetDevice(&dev);
    hipDeviceGetAttribute(&cus, hipDeviceAttributeMultiprocessorCount, dev);
    if (hipFuncSetAttribute((const void*)mega, hipFuncAttributeMaxDynamicSharedMemorySize, LDS_BYTES) != hipSuccess) {
      fprintf(stderr, "kernel_launch: hipFuncSetAttribute failed\n"); grid = -1; return;
    }
    hipOccupancyMaxActiveBlocksPerMultiprocessor(&per_cu, (const void*)mega, NTHR, LDS_BYTES);
    if (per_cu < 1) { fprintf(stderr, "kernel_launch: occupancy query says %d blocks/CU\n", per_cu); per_cu = 1; }
    (void)hipGetLastError();
    grid = cus;
  }
  if (grid < 0) return;
  P p{};
  const float** pp = (const float**)&p;
  for (int i = 0; i < 29; ++i) pp[i] = (const float*)d_in[i];
  p.out = (float*)d_out;
  p.ws = (unsigned char*)d_ws;
  p.ph_lo = 0; p.ph_hi = NPHASE;
  if (hipMemsetAsync((char*)d_ws + WS_BAR, 0, BAR_BYTES, stream) != hipSuccess) { fprintf(stderr, "kernel_launch: memset failed\n"); return; }
  void* args[] = {&p};
  hipError_t e = hipLaunchCooperativeKernel((const void*)mega, dim3(grid), dim3(NTHR), args, LDS_BYTES, stream);
  if (e != hipSuccess) fprintf(stderr, "cooperative launch failed: %s (grid %d)\n", hipGetErrorString(e), grid);
}
```
